# Optimizing an MI355X kernel written in HIP

```python
import jax, jax.numpy as jnp
from jax import lax
import numpy as np

D_MODEL = 1024
BATCH = 16
SEQ = 4096
DEPTH = 1
DEC_BATCH = 2
DEC_SEQ = 8192
PAST_LEN = 128

GLA_HEADS = 4
GLA_DK = D_MODEL // 2
GLA_DV = D_MODEL
HEAD_K = GLA_DK // GLA_HEADS
HEAD_V = GLA_DV // GLA_HEADS
GATE_RANK = 16
GATE_TAU = 16.0
CHUNK = 64
CONV_DIM = D_MODEL
CONV_WIDTH = 3
N_EXPERTS = 16
EC_FACTOR = 2
D_EXPERT = 2816
EPS = 1e-6
IN_SIZES = (GLA_DK, GLA_DK, GLA_DV, GLA_DV, GATE_RANK, GATE_RANK, CONV_DIM, CONV_DIM, CONV_DIM, D_MODEL, D_MODEL)
D_IN = 2 * GLA_DK + 2 * GLA_DV + 2 * GATE_RANK + 3 * CONV_DIM + 2 * D_MODEL

kernel_name = "hybrid_gla_shortconv_ec_moe_encoder"


def _split_points():
    pts, acc = [], 0
    for s in IN_SIZES[:-1]:
        acc += s
        pts.append(acc)
    return pts


def rmsnorm(x, w):
    xf = x.astype(jnp.float32)
    xf = xf * lax.rsqrt(jnp.mean(xf * xf, axis=-1, keepdims=True) + EPS)
    return (xf * w.astype(jnp.float32)).astype(x.dtype)


def gla_one_direction(q, k, v, log_a):
    B, L, H, dk = q.shape
    dv = v.shape[-1]
    n = L // CHUNK
    q = q.reshape(B, n, CHUNK, H, dk)
    k = k.reshape(B, n, CHUNK, H, dk)
    v = v.reshape(B, n, CHUNK, H, dv)
    b = jnp.cumsum(log_a.reshape(B, n, CHUNK, H, dk), axis=2)
    b_last = b[:, :, -1:]
    q_t = q * jnp.exp(b)
    k_t = k * jnp.exp(-b)
    k_end = k * jnp.exp(b_last - b)
    mask = jnp.tril(jnp.ones((CHUNK, CHUNK), dtype=bool))
    att = jnp.einsum('bnihd,bnjhd->bnhij', q_t, k_t)
    att = jnp.where(mask, att, 0.0)
    o_intra = jnp.einsum('bnhij,bnjhv->bnihv', att, v)
    decay = jnp.exp(b_last[:, :, 0])

    def step(S, xs):
        qc, kc, vc, dc = xs
        o = jnp.einsum('bihd,bhdv->bihv', qc, S)
        S = dc[..., None] * S + jnp.einsum('bjhd,bjhv->bhdv', kc, vc)
        return S, o

    S0 = jnp.zeros((B, H, dk, dv), jnp.float32)
    xs = (jnp.moveaxis(q_t, 1, 0), jnp.moveaxis(k_end, 1, 0), jnp.moveaxis(v, 1, 0), jnp.moveaxis(decay, 1, 0))
    _, o_inter = lax.scan(step, S0, xs)
    o = o_intra + jnp.moveaxis(o_inter, 0, 1)
    return o.reshape(B, L, H, dv)


def token_mixer(u, w_in, w_alpha_f, b_alpha_f, w_alpha_b, b_alpha_b, gla_norm_w,
                conv_w, conv_b, w_out_a, w_out_b, w_o):
    B, L, _ = u.shape
    f32 = jnp.float32
    z = u @ w_in
    q, k, v, r, lr_f, lr_b, cb, cc, cx, ga, gb = jnp.split(z, _split_points(), axis=-1)

    qh = (q.astype(f32) * (HEAD_K ** -0.5)).reshape(B, L, GLA_HEADS, HEAD_K)
    kh = k.astype(f32).reshape(B, L, GLA_HEADS, HEAD_K)
    vh = v.astype(f32).reshape(B, L, GLA_HEADS, HEAD_V)
    la_f = (jax.nn.log_sigmoid((lr_f @ w_alpha_f + b_alpha_f).astype(f32)) / GATE_TAU).reshape(B, L, GLA_HEADS, HEAD_K)
    la_b = (jax.nn.log_sigmoid((lr_b @ w_alpha_b + b_alpha_b).astype(f32)) / GATE_TAU).reshape(B, L, GLA_HEADS, HEAD_K)
    o_f = gla_one_direction(qh, kh, vh, la_f)
    o_b = jnp.flip(gla_one_direction(jnp.flip(qh, 1), jnp.flip(kh, 1), jnp.flip(vh, 1), jnp.flip(la_b, 1)), 1)
    o = o_f + o_b
    o = o * lax.rsqrt(jnp.mean(o * o, axis=-1, keepdims=True) + EPS) * gla_norm_w.astype(f32)
    o = o.reshape(B, L, GLA_DV).astype(u.dtype) * jax.nn.silu(r)
    branch_a = o @ w_out_a

    xc = cc * cx
    xp = jnp.pad(xc, ((0, 0), (1, 1), (0, 0)))
    conv = xp[:, :-2] * conv_w[0] + xp[:, 1:-1] * conv_w[1] + xp[:, 2:] * conv_w[2] + conv_b
    branch_b = (cb * conv) @ w_out_b

    merged = jax.nn.sigmoid(ga) * branch_a + jax.nn.sigmoid(gb) * branch_b
    return merged @ w_o


def expert_choice_ffn(u, w_router, w_gate, w_up, w_down):
    B, L, D = u.shape
    T = B * L
    cap = EC_FACTOR * T // N_EXPERTS
    xt = u.reshape(T, D)
    aff = jax.nn.softmax((xt @ w_router).astype(jnp.float32), axis=-1)
    g, idx = lax.top_k(aff.T, cap)
    xe = xt[idx]
    h = jax.nn.silu(jnp.einsum('ecd,edf->ecf', xe, w_gate)) * jnp.einsum('ecd,edf->ecf', xe, w_up)
    ye = jnp.einsum('ecf,efd->ecd', h, w_down) * g[..., None].astype(u.dtype)
    y = jnp.zeros_like(xt).at[idx.reshape(-1)].add(ye.reshape(-1, D))
    return y.reshape(B, L, D)


def trunk(x, c, w_ada, b_ada, norm1_w, w_in, w_alpha_f, b_alpha_f, w_alpha_b, b_alpha_b,
          gla_norm_w, conv_w, conv_b, w_out_a, w_out_b, w_o, norm2_w, w_router,
          w_gate, w_up, w_down, norm_f_w):
    for l in range(DEPTH):
        mod = jax.nn.silu(c) @ w_ada[l] + b_ada[l]
        sh1, sc1, g1, sh2, sc2, g2 = jnp.split(mod[:, None, :], 6, axis=-1)
        u = rmsnorm(x, norm1_w[l]) * (1.0 + sc1) + sh1
        x = x + g1 * token_mixer(u, w_in[l], w_alpha_f[l], b_alpha_f[l], w_alpha_b[l], b_alpha_b[l],
                                 gla_norm_w[l], conv_w[l], conv_b[l], w_out_a[l], w_out_b[l], w_o[l])
        u = rmsnorm(x, norm2_w[l]) * (1.0 + sc2) + sh2
        x = x + g2 * expert_choice_ffn(u, w_router[l], w_gate[l], w_up[l], w_down[l])
    return rmsnorm(x, norm_f_w)


def setup_inputs(seed: int = 0) -> dict:
    key = jax.random.key(seed)
    ks = jax.random.split(key, 26)
    nrm = jax.random.normal
    D = D_MODEL
    return {
        "x_prompt": nrm(ks[0], (BATCH, SEQ, D), jnp.float32),
        "x_sample": nrm(ks[1], (DEC_BATCH, DEC_SEQ, D), jnp.float32),
        "c_prompt": nrm(ks[2], (BATCH, D), jnp.float32),
        "c_sample": nrm(ks[3], (DEC_BATCH, D), jnp.float32),
        "w_ada": nrm(ks[4], (DEPTH, D, 6 * D), jnp.float32) * (0.3 * D ** -0.5),
        "b_ada": nrm(ks[5], (DEPTH, 6 * D), jnp.float32) * 0.02,
        "norm1_w": 1.0 + 0.02 * nrm(ks[6], (DEPTH, D), jnp.float32),
        "w_in": nrm(ks[7], (DEPTH, D, D_IN), jnp.float32) * D ** -0.5,
        "w_alpha_f": nrm(ks[8], (DEPTH, GATE_RANK, GLA_DK), jnp.float32) * GATE_RANK ** -0.5,
        "b_alpha_f": 0.1 * nrm(ks[9], (DEPTH, GLA_DK), jnp.float32),
        "w_alpha_b": nrm(ks[10], (DEPTH, GATE_RANK, GLA_DK), jnp.float32) * GATE_RANK ** -0.5,
        "b_alpha_b": 0.1 * nrm(ks[11], (DEPTH, GLA_DK), jnp.float32),
        "gla_norm_w": 1.0 + 0.02 * nrm(ks[12], (DEPTH, GLA_HEADS, HEAD_V), jnp.float32),
        "conv_w": nrm(ks[13], (DEPTH, CONV_WIDTH, CONV_DIM), jnp.float32) * CONV_WIDTH ** -0.5,
        "conv_b": 0.02 * nrm(ks[14], (DEPTH, CONV_DIM), jnp.float32),
        "w_out_a": nrm(ks[15], (DEPTH, GLA_DV, D), jnp.float32) * GLA_DV ** -0.5,
        "w_out_b": nrm(ks[16], (DEPTH, CONV_DIM, D), jnp.float32) * CONV_DIM ** -0.5,
        "w_o": nrm(ks[17], (DEPTH, D, D), jnp.float32) * D ** -0.5,
        "norm2_w": 1.0 + 0.02 * nrm(ks[18], (DEPTH, D), jnp.float32),
        "w_router": nrm(ks[19], (DEPTH, D, N_EXPERTS), jnp.float32) * D ** -0.5,
        "w_gate": nrm(ks[20], (DEPTH, N_EXPERTS, D, D_EXPERT), jnp.float32) * D ** -0.5,
        "w_up": nrm(ks[21], (DEPTH, N_EXPERTS, D, D_EXPERT), jnp.float32) * D ** -0.5,
        "w_down": nrm(ks[22], (DEPTH, N_EXPERTS, D_EXPERT, D), jnp.float32) * D_EXPERT ** -0.5,
        "norm_f_w": 1.0 + 0.02 * nrm(ks[23], (D,), jnp.float32),
    }


def reference(x_prompt, x_sample, c_prompt, c_sample, w_ada, b_ada, norm1_w, w_in,
              w_alpha_f, b_alpha_f, w_alpha_b, b_alpha_b, gla_norm_w, conv_w, conv_b,
              w_out_a, w_out_b, w_o, norm2_w, w_router, w_gate, w_up, w_down, norm_f_w):
    y_prompt = trunk(x_prompt, c_prompt, w_ada, b_ada, norm1_w, w_in, w_alpha_f, b_alpha_f,
                     w_alpha_b, b_alpha_b, gla_norm_w, conv_w, conv_b, w_out_a, w_out_b, w_o,
                     norm2_w, w_router, w_gate, w_up, w_down, norm_f_w)
    y_sample = trunk(x_sample, c_sample, w_ada, b_ada, norm1_w, w_in, w_alpha_f, b_alpha_f,
                     w_alpha_b, b_alpha_b, gla_norm_w, conv_w, conv_b, w_out_a, w_out_b, w_o,
                     norm2_w, w_router, w_gate, w_up, w_down, norm_f_w)
    return (y_prompt, y_sample)
```

```cpp
#include <hip/hip_runtime.h>
#include <hip/hip_cooperative_groups.h>
#include <cstdio>
namespace cg = cooperative_groups;

#ifndef PM
#define PM 0xFFFFF
#endif
#ifndef DBG_MASK
#define DBG_MASK 0
#endif
#ifndef MEGA
#define MEGA 1
#endif

#define LAS __attribute__((address_space(3)))
typedef unsigned short bf16_t;
typedef short bf16x8 __attribute__((ext_vector_type(8)));
typedef float f32x2 __attribute__((ext_vector_type(2)));
typedef float f32x4 __attribute__((ext_vector_type(4)));
typedef float f32x16 __attribute__((ext_vector_type(16)));
typedef unsigned u32x2 __attribute__((ext_vector_type(2)));
typedef unsigned u32x4 __attribute__((ext_vector_type(4)));

constexpr int NT = 81920;
constexpr int T0 = 65536;
constexpr int DM = 1024;
constexpr int DIN = 8224;
constexpr int NE = 16;
constexpr int DE = 2816;
constexpr int ROWS_E = 10240;
constexpr int ROWS_B = 40960;
constexpr float EPS = 1e-6f;
constexpr int LDS_BYTES = 131072;
constexpr int NTHREADS = 512;

constexpr size_t U = (size_t)NT * DM * 2;
constexpr size_t WS_S0 = 0, WS_S1 = U, WS_S2 = 2 * U, WS_S3 = 3 * U, WS_S4 = 4 * U, WS_S5 = 5 * U;
constexpr size_t WS_WB1 = 6 * U;
constexpr size_t WS_WBA = WS_WB1 + (size_t)8448 * 1024 * 2;
constexpr size_t WS_WBB = WS_WBA + (size_t)1024 * 1024 * 2;
constexpr size_t WS_WBO = WS_WBB + (size_t)1024 * 1024 * 2;
constexpr size_t WS_LR = WS_WBO + (size_t)1024 * 1024 * 2;
constexpr size_t WS_TAIL = ((size_t)1 << 30) - ((size_t)16 << 20);
constexpr size_t WS_MOD = WS_TAIL;
constexpr size_t WS_AFFT = WS_TAIL + ((size_t)512 << 10);
constexpr size_t WS_TOKOF = WS_AFFT + ((size_t)5 << 20);
constexpr size_t WS_GVAL = WS_TOKOF + ((size_t)640 << 10);
constexpr size_t WS_SLOTOF = WS_GVAL + ((size_t)640 << 10);
constexpr size_t WS_WGU = U;
constexpr size_t WS_WDN = WS_WGU + (size_t)16 * 5632 * 1024 * 2;
constexpr size_t WS_H = WS_WDN + (size_t)16 * 1024 * 2816 * 2;
constexpr size_t WS_YE = WS_H + (size_t)ROWS_B * DE * 2;
static_assert(WS_LR + (size_t)NT * 32 * 4 <= WS_TAIL, "ws map");
static_assert(WS_YE + 2 * U <= WS_TAIL, "ws map");
static_assert(WS_SLOTOF + (size_t)NT * 16 * 4 <= ((size_t)1 << 30), "ws map");

struct Params {
    const float* in[24];
    float* out;
    unsigned char* ws;
    int ph_lo, ph_hi, coop, pad;
};
enum { I_XP = 0, I_XS, I_CP, I_CS, I_WADA, I_BADA, I_N1W, I_WIN, I_WAF, I_BAF, I_WAB, I_BAB, I_GNW, I_CW, I_CB, I_WOA, I_WOB, I_WO, I_N2W, I_WR, I_WG, I_WU, I_WD, I_NFW };

typedef __bf16 bf16x2_t __attribute__((ext_vector_type(2)));
__device__ __forceinline__ unsigned pk_bf16(float lo, float hi) { bf16x2_t v = {(__bf16)lo, (__bf16)hi}; return __builtin_bit_cast(unsigned, v); }
__device__ __forceinline__ float bf_lo(unsigned w) { return __uint_as_float(w << 16); }
__device__ __forceinline__ float bf_hi(unsigned w) { return __uint_as_float(w & 0xffff0000u); }
__device__ __forceinline__ float fast_sigmoid(float x) { return __builtin_amdgcn_rcpf(1.0f + __expf(-x)); }
__device__ __forceinline__ float wave_sum(float v) {
#pragma unroll
    for (int m = 32; m >= 1; m >>= 1) v += __shfl_xor(v, m);
    return v;
}
__device__ __forceinline__ int otid() { int t = threadIdx.x; asm volatile("" : "+v"(t)); return t; }
__device__ __forceinline__ int batch_of_row(int row) { return row < T0 ? (row >> 12) : 16 + ((row - T0) >> 13); }
__device__ __forceinline__ const float* x_row(const Params& P, int row) { return row < T0 ? P.in[I_XP] + (size_t)row * DM : P.in[I_XS] + (size_t)(row - T0) * DM; }

__device__ void phase_mod(LAS unsigned char* lds, const Params& P) {
    LAS float* sc = (LAS float*)lds;
    float* MOD = (float*)(P.ws + WS_MOD);
    const int tid = otid();
    for (int chunk = blockIdx.x; chunk < 18 * 12; chunk += gridDim.x) {
        const int b = chunk / 12, j = (chunk % 12) * 512 + tid;
        const float* c = b < 16 ? P.in[I_CP] + b * DM : P.in[I_CS] + (b - 16) * DM;
        __syncthreads();
        for (int k = tid; k < DM; k += NTHREADS) { float v = c[k]; sc[k] = v / (1.0f + __expf(-v)); }
        __syncthreads();
        const float* w = P.in[I_WADA] + j;
        float a0 = 0.f, a1 = 0.f, a2 = 0.f, a3 = 0.f;
        for (int k = 0; k < DM; k += 4) {
            a0 += sc[k] * w[(size_t)k * 6144];
            a1 += sc[k + 1] * w[(size_t)(k + 1) * 6144];
            a2 += sc[k + 2] * w[(size_t)(k + 2) * 6144];
            a3 += sc[k + 3] * w[(size_t)(k + 3) * 6144];
        }
        MOD[b * 6144 + j] = (a0 + a1) + (a2 + a3) + P.in[I_BADA][j];
    }
    __syncthreads();
}

__device__ __forceinline__ void convert_tile(LAS unsigned char* lds, const float* src, int ld_src, int colA, int colB, float scale, int k0, bf16_t* dst, int ld_dst) {
    LAS float* tile = (LAS float*)lds;
    const int tid = otid();
    {
        const int n = tid & 63, kk = tid >> 6;
        const int col = n < 32 ? (colA < 0 ? -1 : colA + n) : (colB < 0 ? -1 : colB + n - 32);
        const float* s = src + (size_t)(k0 + kk) * ld_src + (col < 0 ? 0 : col);
#pragma unroll
        for (int pass = 0; pass < 16; ++pass) {
            float v = col < 0 ? 0.f : s[(size_t)pass * 8 * ld_src] * scale;
            tile[(pass * 8 + kk) * 65 + n] = v;
        }
    }
    __syncthreads();
    {
        const int n = tid >> 3, ks = tid & 7;
        unsigned w[8];
#pragma unroll
        for (int j = 0; j < 8; ++j) w[j] = pk_bf16(tile[(ks * 16 + 2 * j) * 65 + n], tile[(ks * 16 + 2 * j + 1) * 65 + n]);
        bf16_t* d = dst + (size_t)n * ld_dst + k0 + ks * 16;
        *(u32x4*)d = (u32x4){w[0], w[1], w[2], w[3]};
        *(u32x4*)(d + 8) = (u32x4){w[4], w[5], w[6], w[7]};
    }
    __syncthreads();
}

__device__ __forceinline__ int win_col(int n) {
    if (n < 3072) return n;
    if (n < 3328) { int j = n - 3072; return j < 32 ? 3072 + j : -1; }
    if (n < 5376) { int j = n - 3328, b = j >> 8, w = j & 255; return (w < 128 ? 4128 : 5152) + b * 128 + (w & 127); }
    if (n < 6400) return 3104 + (n - 5376);
    return 6176 + (n - 6400);
}

__device__ void phase_convert_mixer(LAS unsigned char* lds, const Params& P) {
    for (int t = blockIdx.x; t < 1056 + 384; t += gridDim.x) {
        if (t < 1056) {
            const int rt = t >> 3, kt = t & 7, n0 = rt * 64;
            convert_tile(lds, P.in[I_WIN], DIN, win_col(n0), win_col(n0 + 32), n0 < 512 ? 0.08838834764831845f : 1.0f, kt * 128,
                         (bf16_t*)(P.ws + WS_WB1) + (size_t)n0 * 1024, 1024);
        } else {
            const int u = t - 1056, which = u >> 7, rt = (u & 127) >> 3, kt = u & 7, n0 = rt * 64;
            const float* src = P.in[which == 0 ? I_WOA : which == 1 ? I_WOB : I_WO];
            bf16_t* dst = (bf16_t*)(P.ws + (which == 0 ? WS_WBA : which == 1 ? WS_WBB : WS_WBO));
            convert_tile(lds, src, 1024, n0, n0 + 32, 1.0f, kt * 128, dst + (size_t)n0 * 1024, 1024);
        }
    }
}

__device__ void convert_moe(LAS unsigned char* lds, const Params& P, int first, int stride) {
    for (int t = first; t < 16 * 1056; t += stride) {
        const int e = t / 1056, r = t % 1056;
        if (r < 704) {
            const int rt = r >> 3, kt = r & 7, n0 = rt * 64, blk = n0 >> 8, w = n0 & 255;
            const float* src = (w < 128 ? P.in[I_WG] : P.in[I_WU]) + (size_t)e * 1024 * DE;
            const int col = blk * 128 + (w & 127);
            convert_tile(lds, src, DE, col, col + 32, 1.0f, kt * 128, (bf16_t*)(P.ws + WS_WGU) + ((size_t)e * 5632 + n0) * 1024, 1024);
        } else {
            const int r2 = r - 704, rt = r2 / 22, kt = r2 % 22, n0 = rt * 64;
            const float* src = P.in[I_WD] + (size_t)e * DE * 1024;
            convert_tile(lds, src, 1024, n0, n0 + 32, 1.0f, kt * 128, (bf16_t*)(P.ws + WS_WDN) + ((size_t)e * 1024 + n0) * DE, DE);
        }
    }
}

__device__ void phase_norm1(const Params& P) {
    const int tid_ = otid();
    const int lane = tid_ & 63, gw = blockIdx.x * 8 + (tid_ >> 6), nw = gridDim.x * 8;
    const int per = (NT + nw - 1) / nw;
    const int r_lo = gw * per, r_hi = min(NT, r_lo + per);
    const float* MOD = (const float*)(P.ws + WS_MOD);
    bf16_t* Uo = (bf16_t*)(P.ws + WS_S0);
    int curb = -1;
    float A[16], B[16];
    for (int row = r_lo; row < r_hi; ++row) {
        const int b = batch_of_row(row);
        if (b != curb) {
            curb = b;
#pragma unroll
            for (int i = 0; i < 2; ++i)
#pragma unroll
                for (int j = 0; j < 8; ++j) {
                    const int c = 8 * lane + 512 * i + j;
                    A[i * 8 + j] = P.in[I_N1W][c] * (1.0f + MOD[b * 6144 + 1024 + c]);
                    B[i * 8 + j] = MOD[b * 6144 + c];
                }
        }
        const float* xr = x_row(P, row);
        float v[16];
#pragma unroll
        for (int i = 0; i < 2; ++i) {
            const f32x4 a = *(const f32x4*)(xr + 8 * lane + 512 * i), c = *(const f32x4*)(xr + 8 * lane + 512 * i + 4);
            v[i * 8 + 0] = a[0]; v[i * 8 + 1] = a[1]; v[i * 8 + 2] = a[2]; v[i * 8 + 3] = a[3];
            v[i * 8 + 4] = c[0]; v[i * 8 + 5] = c[1]; v[i * 8 + 6] = c[2]; v[i * 8 + 7] = c[3];
        }
        float ss = 0.f;
#pragma unroll
        for (int j = 0; j < 16; ++j) ss += v[j] * v[j];
        ss = wave_sum(ss);
        const float rstd = rsqrtf(ss * (1.0f / 1024.0f) + EPS);
#pragma unroll
        for (int i = 0; i < 2; ++i) {
            unsigned w[4];
#pragma unroll
            for (int j = 0; j < 4; ++j) w[j] = pk_bf16(v[i * 8 + 2 * j] * rstd * A[i * 8 + 2 * j] + B[i * 8 + 2 * j], v[i * 8 + 2 * j + 1] * rstd * A[i * 8 + 2 * j + 1] + B[i * 8 + 2 * j + 1]);
            *(u32x4*)(Uo + (size_t)row * DM + 8 * lane + 512 * i) = (u32x4){w[0], w[1], w[2], w[3]};
        }
    }
}

__device__ void phase_oaprep(const Params& P) {
    const int tid_ = otid();
    const int lane = tid_ & 63, gw = blockIdx.x * 8 + (tid_ >> 6), nw = gridDim.x * 8;
    const bf16_t* OF = (const bf16_t*)P.out;
    const bf16_t* OB = OF + (size_t)NT * DM;
    const bf16_t* R = (const bf16_t*)(P.ws + WS_S3);
    bf16_t* OA = (bf16_t*)(P.ws + WS_S1);
    float g[16];
#pragma unroll
    for (int j = 0; j < 16; ++j) g[j] = P.in[I_GNW][16 * lane + j];
    for (int row = gw; row < NT; row += nw) {
        const size_t off = (size_t)row * DM + 16 * lane;
        const u32x4 f0 = *(const u32x4*)(OF + off), f1 = *(const u32x4*)(OF + off + 8);
        const u32x4 b0 = *(const u32x4*)(OB + off), b1 = *(const u32x4*)(OB + off + 8);
        const u32x4 r0 = *(const u32x4*)(R + off), r1 = *(const u32x4*)(R + off + 8);
        float o[16], rr[16];
#pragma unroll
        for (int j = 0; j < 4; ++j) {
            o[2 * j] = bf_lo(f0[j]) + bf_lo(b0[j]); o[2 * j + 1] = bf_hi(f0[j]) + bf_hi(b0[j]);
            o[8 + 2 * j] = bf_lo(f1[j]) + bf_lo(b1[j]); o[8 + 2 * j + 1] = bf_hi(f1[j]) + bf_hi(b1[j]);
            rr[2 * j] = bf_lo(r0[j]); rr[2 * j + 1] = bf_hi(r0[j]); rr[8 + 2 * j] = bf_lo(r1[j]); rr[8 + 2 * j + 1] = bf_hi(r1[j]);
        }
        float ss = 0.f;
#pragma unroll
        for (int j = 0; j < 16; ++j) ss += o[j] * o[j];
        ss += __shfl_xor(ss, 1); ss += __shfl_xor(ss, 2); ss += __shfl_xor(ss, 4); ss += __shfl_xor(ss, 8);
        const float rstd = rsqrtf(ss * (1.0f / 256.0f) + EPS);
        unsigned w[8];
#pragma unroll
        for (int j = 0; j < 8; ++j) {
            const float a = o[2 * j] * rstd * g[2 * j] * (rr[2 * j] * fast_sigmoid(rr[2 * j]));
            const float c = o[2 * j + 1] * rstd * g[2 * j + 1] * (rr[2 * j + 1] * fast_sigmoid(rr[2 * j + 1]));
            w[j] = pk_bf16(a, c);
        }
        *(u32x4*)(OA + off) = (u32x4){w[0], w[1], w[2], w[3]};
        *(u32x4*)(OA + off + 8) = (u32x4){w[4], w[5], w[6], w[7]};
    }
}

__device__ void phase_norm2(LAS unsigned char* lds, const Params& P) {
    LAS float* wrT = (LAS float*)lds;
    const int tid = otid();
    for (int i = tid; i < DM * NE; i += NTHREADS) wrT[(i & 15) * 1024 + (i >> 4)] = P.in[I_WR][i];
    __syncthreads();
    const int lane = tid & 63, gw = blockIdx.x * 8 + (tid >> 6), nw = gridDim.x * 8;
    const int per = (NT + nw - 1) / nw;
    const int r_lo = gw * per, r_hi = min(NT, r_lo + per);
    const float* MOD = (const float*)(P.ws + WS_MOD);
    const float* X1 = P.out;
    bf16_t* Uo = (bf16_t*)(P.ws + WS_S0);
    float* AFFT = (float*)(P.ws + WS_AFFT);
    int curb = -1;
    float A[16], B[16];
    for (int row = r_lo; row < r_hi; ++row) {
        const int b = batch_of_row(row);
        if (b != curb) {
            curb = b;
#pragma unroll
            for (int i = 0; i < 2; ++i)
#pragma unroll
                for (int j = 0; j < 8; ++j) {
                    const int c = 8 * lane + 512 * i + j;
                    A[i * 8 + j] = P.in[I_N2W][c] * (1.0f + MOD[b * 6144 + 4096 + c]);
                    B[i * 8 + j] = MOD[b * 6144 + 3072 + c];
                }
        }
        const float* xr = X1 + (size_t)row * DM;
        float v[16];
#pragma unroll
        for (int i = 0; i < 2; ++i) {
            const f32x4 a = *(const f32x4*)(xr + 8 * lane + 512 * i), c = *(const f32x4*)(xr + 8 * lane + 512 * i + 4);
            v[i * 8 + 0] = a[0]; v[i * 8 + 1] = a[1]; v[i * 8 + 2] = a[2]; v[i * 8 + 3] = a[3];
            v[i * 8 + 4] = c[0]; v[i * 8 + 5] = c[1]; v[i * 8 + 6] = c[2]; v[i * 8 + 7] = c[3];
        }
        float ss = 0.f;
#pragma unroll
        for (int j = 0; j < 16; ++j) ss += v[j] * v[j];
        ss = wave_sum(ss);
        const float rstd = rsqrtf(ss * (1.0f / 1024.0f) + EPS);
#pragma unroll
        for (int j = 0; j < 16; ++j) v[j] = v[j] * rstd * A[j] + B[j];
#pragma unroll
        for (int i = 0; i < 2; ++i) {
            unsigned w[4];
#pragma unroll
            for (int j = 0; j < 4; ++j) w[j] = pk_bf16(v[i * 8 + 2 * j], v[i * 8 + 2 * j + 1]);
            *(u32x4*)(Uo + (size_t)row * DM + 8 * lane + 512 * i) = (u32x4){w[0], w[1], w[2], w[3]};
        }
        int wo = 0; asm volatile("" : "+v"(wo));
        const LAS float* wrTo = wrT + wo;
        float lg[16];
#pragma unroll
        for (int e = 0; e < 16; ++e) {
            float s = 0.f;
#pragma unroll
            for (int i = 0; i < 2; ++i) {
                const f32x4 w0 = *(const LAS f32x4*)(wrTo + e * 1024 + 8 * lane + 512 * i), w1 = *(const LAS f32x4*)(wrTo + e * 1024 + 8 * lane + 512 * i + 4);
                s += v[i * 8 + 0] * w0[0] + v[i * 8 + 1] * w0[1] + v[i * 8 + 2] * w0[2] + v[i * 8 + 3] * w0[3];
                s += v[i * 8 + 4] * w1[0] + v[i * 8 + 5] * w1[1] + v[i * 8 + 6] * w1[2] + v[i * 8 + 7] * w1[3];
            }
            lg[e] = s;
        }
        float t8[8], t4[4], t2[2], t1;
        {
            const bool hi = lane & 1;
#pragma unroll
            for (int i = 0; i < 8; ++i) { const float keep = hi ? lg[2 * i + 1] : lg[2 * i], send = hi ? lg[2 * i] : lg[2 * i + 1]; t8[i] = keep + __shfl_xor(send, 1); }
        }
        {
            const bool hi = lane & 2;
#pragma unroll
            for (int i = 0; i < 4; ++i) { const float keep = hi ? t8[2 * i + 1] : t8[2 * i], send = hi ? t8[2 * i] : t8[2 * i + 1]; t4[i] = keep + __shfl_xor(send, 2); }
        }
        {
            const bool hi = lane & 4;
#pragma unroll
            for (int i = 0; i < 2; ++i) { const float keep = hi ? t4[2 * i + 1] : t4[2 * i], send = hi ? t4[2 * i] : t4[2 * i + 1]; t2[i] = keep + __shfl_xor(send, 4); }
        }
        {
            const bool hi = lane & 8;
            const float keep = hi ? t2[1] : t2[0], send = hi ? t2[0] : t2[1]; t1 = keep + __shfl_xor(send, 8);
        }
        t1 += __shfl_xor(t1, 16); t1 += __shfl_xor(t1, 32);
        float mx = t1;
        mx = fmaxf(mx, __shfl_xor(mx, 1)); mx = fmaxf(mx, __shfl_xor(mx, 2)); mx = fmaxf(mx, __shfl_xor(mx, 4)); mx = fmaxf(mx, __shfl_xor(mx, 8));
        const float ex = expf(t1 - mx);
        float sm = ex;
        sm += __shfl_xor(sm, 1); sm += __shfl_xor(sm, 2); sm += __shfl_xor(sm, 4); sm += __shfl_xor(sm, 8);
        if (lane < 16) AFFT[(size_t)lane * NT + row] = ex / sm;
    }
    __syncthreads();
}

__device__ int block_find_bin(LAS int* hist, LAS int* scr, int nbins_per_thread, int k, int& krem) {
    const int tid = otid();
    int loc = 0;
    for (int j = 0; j < nbins_per_thread; ++j) loc += hist[tid * nbins_per_thread + j];
    scr[tid] = loc;
    __syncthreads();
    for (int d = 1; d < 512; d <<= 1) {
        int v = (tid + d < 512) ? scr[tid + d] : 0;
        __syncthreads();
        scr[tid] += v;
        __syncthreads();
    }
    const int suf_incl = scr[tid], suf_excl = suf_incl - loc;
    if (suf_excl < k && suf_incl >= k) {
        int run = suf_excl;
        for (int j = nbins_per_thread - 1; j >= 0; --j) {
            const int h = hist[tid * nbins_per_thread + j];
            if (run + h >= k) { scr[512] = tid * nbins_per_thread + j; scr[513] = k - run; break; }
            run += h;
        }
    }
    __syncthreads();
    const int bin = scr[512];
    krem = scr[513];
    __syncthreads();
    return bin;
}

__device__ void phase_topk_item(LAS unsigned char* lds, const Params& P, int item) {
    LAS int* hist = (LAS int*)lds;
    LAS int* scr = (LAS int*)(lds + 16384);
    LAS int* scr2 = (LAS int*)(lds + 16384 + 4096);
    const int tid = otid();
    const int g = item >> 4, e = item & 15;
    const int t0 = g ? T0 : 0, T = g ? 16384 : 65536, cap = T >> 3;
    const unsigned* v = (const unsigned*)(P.ws + WS_AFFT) + (size_t)e * NT + t0;
    int k = cap, krem;
    for (int i = tid; i < 4096; i += NTHREADS) hist[i] = 0;
    __syncthreads();
    for (int t = tid; t < T; t += NTHREADS) atomicAdd((int*)&hist[v[t] >> 20], 1);
    __syncthreads();
    const unsigned p1 = (unsigned)block_find_bin(hist, scr, 8, k, krem); k = krem;
    for (int i = tid; i < 4096; i += NTHREADS) hist[i] = 0;
    __syncthreads();
    for (int t = tid; t < T; t += NTHREADS) { const unsigned x = v[t]; if ((x >> 20) == p1) atomicAdd((int*)&hist[(x >> 8) & 4095], 1); }
    __syncthreads();
    const unsigned p2 = (unsigned)block_find_bin(hist, scr, 8, k, krem); k = krem;
    for (int i = tid; i < 512; i += NTHREADS) hist[i] = 0;
    __syncthreads();
    const unsigned p12 = (p1 << 12) | p2;
    for (int t = tid; t < T; t += NTHREADS) { const unsigned x = v[t]; if ((x >> 8) == p12) atomicAdd((int*)&hist[x & 255], 1); }
    __syncthreads();
    const unsigned p3 = (unsigned)block_find_bin(hist, scr, 1, k, krem);
    const unsigned thr = (p12 << 8) | p3;
    const int keq = krem;
    const int len = T / NTHREADS, lo = tid * len;
    int cg_ = 0, ce = 0;
    for (int i = 0; i < len; ++i) { const unsigned x = v[lo + i]; cg_ += x > thr; ce += x == thr; }
    scr[tid] = cg_; scr2[tid] = ce;
    __syncthreads();
    for (int d = 1; d < 512; d <<= 1) {
        const int a = tid >= d ? scr[tid - d] : 0, b = tid >= d ? scr2[tid - d] : 0;
        __syncthreads();
        scr[tid] += a; scr2[tid] += b;
        __syncthreads();
    }
    int gt_run = scr[tid] - cg_, eq_run = scr2[tid] - ce;
    int* TOKOF = (int*)(P.ws + WS_TOKOF);
    float* GVAL = (float*)(P.ws + WS_GVAL);
    int* SLOTOF = (int*)(P.ws + WS_SLOTOF);
    const int rbase = e * ROWS_E + (g ? 8192 : 0);
    for (int i = 0; i < len; ++i) {
        const unsigned x = v[lo + i];
        const bool isg = x > thr, ise = x == thr;
        const bool sel = isg || (ise && eq_run < keq);
        const int slot = gt_run + min(eq_run, keq);
        const int trow = t0 + lo + i;
        if (sel) { TOKOF[rbase + slot] = trow; GVAL[rbase + slot] = __uint_as_float(x); SLOTOF[(size_t)trow * 16 + e] = rbase + slot; }
        else SLOTOF[(size_t)trow * 16 + e] = -1;
        gt_run += isg; eq_run += ise;
    }
    __syncthreads();
}

__device__ void phase_final(const Params& P) {
    const int tid_ = otid();
    const int lane = tid_ & 63, gw = blockIdx.x * 8 + (tid_ >> 6), nw = gridDim.x * 8;
    const float* MOD = (const float*)(P.ws + WS_MOD);
    const int* SLOTOF = (const int*)(P.ws + WS_SLOTOF);
    const bf16_t* YE = (const bf16_t*)(P.ws + WS_YE);
    float wf[16];
#pragma unroll
    for (int i = 0; i < 2; ++i)
#pragma unroll
        for (int j = 0; j < 8; ++j) wf[i * 8 + j] = P.in[I_NFW][8 * lane + 512 * i + j];
    for (int row = gw; row < NT; row += nw) {
        const int b = batch_of_row(row);
        float* xr = P.out + (size_t)row * DM;
        float v[16], acc[16];
#pragma unroll
        for (int i = 0; i < 2; ++i) {
            const f32x4 a = *(const f32x4*)(xr + 8 * lane + 512 * i), c = *(const f32x4*)(xr + 8 * lane + 512 * i + 4);
            v[i * 8 + 0] = a[0]; v[i * 8 + 1] = a[1]; v[i * 8 + 2] = a[2]; v[i * 8 + 3] = a[3];
            v[i * 8 + 4] = c[0]; v[i * 8 + 5] = c[1]; v[i * 8 + 6] = c[2]; v[i * 8 + 7] = c[3];
        }
#pragma unroll
        for (int j = 0; j < 16; ++j) acc[j] = 0.f;
        const int myslot = SLOTOF[(size_t)row * 16 + (lane & 15)];
        for (int e = 0; e < 16; ++e) {
            const int s = __shfl(myslot, e);
            if (s >= 0) {
#pragma unroll
                for (int i = 0; i < 2; ++i) {
                    const u32x4 y = *(const u32x4*)(YE + (size_t)s * DM + 8 * lane + 512 * i);
#pragma unroll
                    for (int j = 0; j < 4; ++j) { acc[i * 8 + 2 * j] += bf_lo(y[j]); acc[i * 8 + 2 * j + 1] += bf_hi(y[j]); }
                }
            }
        }
        float ss = 0.f;
#pragma unroll
        for (int i = 0; i < 2; ++i)
#pragma unroll
            for (int j = 0; j < 8; ++j) {
                const float g2 = MOD[b * 6144 + 5120 + 8 * lane + 512 * i + j];
                v[i * 8 + j] += g2 * acc[i * 8 + j];
                ss += v[i * 8 + j] * v[i * 8 + j];
            }
        ss = wave_sum(ss);
        const float rstd = rsqrtf(ss * (1.0f / 1024.0f) + EPS);
#pragma unroll
        for (int i = 0; i < 2; ++i) {
            *(f32x4*)(xr + 8 * lane + 512 * i) = (f32x4){v[i * 8 + 0] * rstd * wf[i * 8 + 0], v[i * 8 + 1] * rstd * wf[i * 8 + 1], v[i * 8 + 2] * rstd * wf[i * 8 + 2], v[i * 8 + 3] * rstd * wf[i * 8 + 3]};
            *(f32x4*)(xr + 8 * lane + 512 * i + 4) = (f32x4){v[i * 8 + 4] * rstd * wf[i * 8 + 4], v[i * 8 + 5] * rstd * wf[i * 8 + 5], v[i * 8 + 6] * rstd * wf[i * 8 + 6], v[i * 8 + 7] * rstd * wf[i * 8 + 7]};
        }
    }
}

constexpr int G_LRS = 0, G_GT = 4096, G_DEC = 8192, G_QT = 8704, G_KT = G_QT + 17408, G_KET = G_KT + 17408, G_VT = G_KET + 18432, G_ATT = G_VT + 9216, G_ST = G_ATT + 9216;
static_assert(G_ST + 2 * 17408 <= LDS_BYTES, "gla lds");

__device__ void gla_item(LAS unsigned char* lds, const Params& P, int seq, int head, int dir, int vs) {
    const int tid = otid(), wid = tid >> 6, lane = tid & 63;
    const int r0 = seq < 16 ? seq * 4096 : T0 + (seq - 16) * 8192, L = seq < 16 ? 4096 : 8192, nch = L >> 6;
    const int p = lane, tg = wid;
    const unsigned char* QK = P.ws + WS_S1;
    const unsigned char* V = P.ws + WS_S2;
    const float* LR = (const float*)(P.ws + WS_LR);
    unsigned char* O = (unsigned char*)P.out + (dir ? U : 0);
    float wa[16][2], bias[2];
    {
        const float* w = P.in[dir ? I_WAB : I_WAF] + head * 128 + 2 * p;
#pragma unroll
        for (int r = 0; r < 16; ++r) { const f32x2 t = *(const f32x2*)(w + r * 512); wa[r][0] = t[0]; wa[r][1] = t[1]; }
        const f32x2 t = *(const f32x2*)(P.in[dir ? I_BAB : I_BAF] + head * 128 + 2 * p);
        bias[0] = t[0]; bias[1] = t[1];
    }
    f32x16 Sacc;
#pragma unroll
    for (int i = 0; i < 16; ++i) Sacc[i] = 0.f;
    unsigned q2[8], k2[8]; u32x4 vv; f32x4 lrv = {0.f, 0.f, 0.f, 0.f};
    auto load_chunk = [&](int ci) {
        const int rc = r0 + ci * 64;
#pragma unroll
        for (int i = 0; i < 8; ++i) {
            const unsigned char* rp = QK + (size_t)(rc + 8 * tg + i) * 2048 + (head * 128 + 2 * p) * 2;
            q2[i] = *(const unsigned*)rp; k2[i] = *(const unsigned*)(rp + 1024);
        }
        vv = *(const u32x4*)(V + (size_t)(rc + (tid >> 3)) * 2048 + (head * 256 + vs * 64 + (tid & 7) * 8) * 2);
        if (tid < 256) lrv = *(const f32x4*)(LR + (size_t)(rc + (tid >> 2)) * 32 + dir * 16 + (tid & 3) * 4);
    };
    load_chunk(dir ? nch - 1 : 0);
    const int mi = wid >> 1, ni = wid & 1, c31 = lane & 31, hh = lane >> 5, l15 = lane & 15, l4 = lane >> 4;
    for (int step = 0; step < nch; ++step) {
        const int ci = dir ? nch - 1 - step : step, rc = r0 + ci * 64, buf = step & 1;
        LAS unsigned char* ST = lds + G_ST + buf * 17408;
        if (tid < 256) *(LAS f32x4*)(lds + G_LRS + (tid >> 2) * 64 + (tid & 3) * 16) = lrv;
#pragma unroll
        for (int g = 0; g < 4; ++g)
            *(LAS u32x2*)(ST + (32 * ni + c31) * 272 + (32 * mi + 8 * g + 4 * hh) * 2) = (u32x2){pk_bf16(Sacc[4 * g], Sacc[4 * g + 1]), pk_bf16(Sacc[4 * g + 2], Sacc[4 * g + 3])};
        __syncthreads();
        float c[8][2];
#pragma unroll
        for (int i = 0; i < 8; ++i) {
            const LAS f32x4* lp = (const LAS f32x4*)(lds + G_LRS + (8 * tg + i) * 64);
            float x0 = bias[0], x1 = bias[1];
#pragma unroll
            for (int r4 = 0; r4 < 4; ++r4) {
                const f32x4 l = lp[r4];
#pragma unroll
                for (int r = 0; r < 4; ++r) { x0 += l[r] * wa[r4 * 4 + r][0]; x1 += l[r] * wa[r4 * 4 + r][1]; }
            }
            c[i][0] = (fminf(x0, 0.f) - __logf(1.0f + __expf(-fabsf(x0)))) * 0.0625f;
            c[i][1] = (fminf(x1, 0.f) - __logf(1.0f + __expf(-fabsf(x1)))) * 0.0625f;
        }
        if (dir == 0) {
#pragma unroll
            for (int i = 1; i < 8; ++i) { c[i][0] += c[i - 1][0]; c[i][1] += c[i - 1][1]; }
            *(LAS f32x2*)(lds + G_GT + (tg * 128 + 2 * p) * 4) = (f32x2){c[7][0], c[7][1]};
        } else {
#pragma unroll
            for (int i = 6; i >= 0; --i) { c[i][0] += c[i + 1][0]; c[i][1] += c[i + 1][1]; }
            *(LAS f32x2*)(lds + G_GT + (tg * 128 + 2 * p) * 4) = (f32x2){c[0][0], c[0][1]};
        }
        __syncthreads();
        float off0 = 0.f, off1 = 0.f, tot0 = 0.f, tot1 = 0.f;
#pragma unroll
        for (int g = 0; g < 8; ++g) {
            const f32x2 t = *(const LAS f32x2*)(lds + G_GT + (g * 128 + 2 * p) * 4);
            tot0 += t[0]; tot1 += t[1];
            const bool inc = dir == 0 ? (g < tg) : (g > tg);
            off0 += inc ? t[0] : 0.f; off1 += inc ? t[1] : 0.f;
        }
        const float dec0 = __expf(tot0), dec1 = __expf(tot1);
        {
            unsigned ke0[4], ke1[4];
            float pe0 = 0.f, pe1 = 0.f;
#pragma unroll
            for (int i = 0; i < 8; ++i) {
                const float b0 = c[i][0] + off0, b1 = c[i][1] + off1;
                const float eq0 = __expf(b0), eq1 = __expf(b1), ek0 = __expf(-b0), ek1 = __expf(-b1);
                const float kl = bf_lo(k2[i]), kh = bf_hi(k2[i]);
                const int tok = 8 * tg + i;
                *(LAS unsigned*)(lds + G_QT + tok * 272 + 4 * p) = pk_bf16(bf_lo(q2[i]) * eq0, bf_hi(q2[i]) * eq1);
                *(LAS unsigned*)(lds + G_KT + tok * 272 + 4 * p) = pk_bf16(kl * ek0, kh * ek1);
                const float e0 = kl * ek0 * dec0, e1 = kh * ek1 * dec1;
                if (i & 1) { ke0[i >> 1] = pk_bf16(pe0, e0); ke1[i >> 1] = pk_bf16(pe1, e1); } else { pe0 = e0; pe1 = e1; }
            }
            *(LAS u32x4*)(lds + G_KET + (2 * p) * 144 + 16 * tg) = (u32x4){ke0[0], ke0[1], ke0[2], ke0[3]};
            *(LAS u32x4*)(lds + G_KET + (2 * p + 1) * 144 + 16 * tg) = (u32x4){ke1[0], ke1[1], ke1[2], ke1[3]};
            if (tg == 0) *(LAS f32x2*)(lds + G_DEC + 8 * p) = (f32x2){dec0, dec1};
        }
        {
            const int tok = tid >> 3, seg = tid & 7;
#pragma unroll
            for (int j = 0; j < 4; ++j) {
                *(LAS unsigned short*)(lds + G_VT + (seg * 8 + 2 * j) * 144 + tok * 2) = (unsigned short)(vv[j] & 0xffffu);
                *(LAS unsigned short*)(lds + G_VT + (seg * 8 + 2 * j + 1) * 144 + tok * 2) = (unsigned short)(vv[j] >> 16);
            }
        }
        if (step + 1 < nch) load_chunk(dir ? nch - 2 - step : step + 1);
        __syncthreads();
        {
            const int ti = wid >> 1;
#pragma unroll
            for (int tt = 0; tt < 2; ++tt) {
                const int tj = (wid & 1) * 2 + tt;
                f32x4 a4 = {0.f, 0.f, 0.f, 0.f};
                const bool skip = dir == 0 ? (tj > ti) : (tj < ti);
                if (!skip) {
#pragma unroll
                    for (int kk = 0; kk < 4; ++kk) {
                        const bf16x8 X = *(const LAS bf16x8*)(lds + G_KT + (tj * 16 + l15) * 272 + (kk * 32 + l4 * 8) * 2);
                        const bf16x8 Y = *(const LAS bf16x8*)(lds + G_QT + (ti * 16 + l15) * 272 + (kk * 32 + l4 * 8) * 2);
                        a4 = __builtin_amdgcn_mfma_f32_16x16x32_bf16(X, Y, a4, 0, 0, 0);
                    }
                }
                const int i = ti * 16 + l15, j0 = tj * 16 + 4 * l4;
#pragma unroll
                for (int r = 0; r < 4; ++r) { const bool keep = dir == 0 ? (j0 + r <= i) : (j0 + r >= i); a4[r] = keep ? a4[r] : 0.f; }
                *(LAS u32x2*)(lds + G_ATT + i * 144 + j0 * 2) = (u32x2){pk_bf16(a4[0], a4[1]), pk_bf16(a4[2], a4[3])};
            }
        }
        __syncthreads();
        {
            const int ti = wid >> 1;
#pragma unroll
            for (int tt = 0; tt < 2; ++tt) {
                const int tn = (wid & 1) * 2 + tt;
                f32x4 a4 = {0.f, 0.f, 0.f, 0.f};
#pragma unroll
                for (int kk = 0; kk < 2; ++kk) {
                    const bf16x8 X = *(const LAS bf16x8*)(lds + G_VT + (tn * 16 + l15) * 144 + (kk * 32 + l4 * 8) * 2);
                    const bf16x8 Y = *(const LAS bf16x8*)(lds + G_ATT + (ti * 16 + l15) * 144 + (kk * 32 + l4 * 8) * 2);
                    a4 = __builtin_amdgcn_mfma_f32_16x16x32_bf16(X, Y, a4, 0, 0, 0);
                }
#pragma unroll
                for (int kk = 0; kk < 4; ++kk) {
                    const bf16x8 X = *(const LAS bf16x8*)(ST + (tn * 16 + l15) * 272 + (kk * 32 + l4 * 8) * 2);
                    const bf16x8 Y = *(const LAS bf16x8*)(lds + G_QT + (ti * 16 + l15) * 272 + (kk * 32 + l4 * 8) * 2);
                    a4 = __builtin_amdgcn_mfma_f32_16x16x32_bf16(X, Y, a4, 0, 0, 0);
                }
                const int tok = ti * 16 + l15, dv = tn * 16 + 4 * l4;
                *(u32x2*)(O + (size_t)(rc + tok) * 2048 + (head * 256 + vs * 64 + dv) * 2) = (u32x2){pk_bf16(a4[0], a4[1]), pk_bf16(a4[2], a4[3])};
            }
#pragma unroll
            for (int g = 0; g < 4; ++g) {
                const f32x4 d4 = *(const LAS f32x4*)(lds + G_DEC + (32 * mi + 8 * g + 4 * hh) * 4);
#pragma unroll
                for (int r = 0; r < 4; ++r) Sacc[4 * g + r] *= d4[r];
            }
#pragma unroll
            for (int kk = 0; kk < 4; ++kk) {
                const bf16x8 A = *(const LAS bf16x8*)(lds + G_KET + (32 * mi + c31) * 144 + (16 * kk + 8 * hh) * 2);
                const bf16x8 B = *(const LAS bf16x8*)(lds + G_VT + (32 * ni + c31) * 144 + (16 * kk + 8 * hh) * 2);
                Sacc = __builtin_amdgcn_mfma_f32_32x32x16_bf16(A, B, Sacc, 0, 0, 0);
            }
        }
    }
    __syncthreads();
}

__device__ void phase_gla(LAS unsigned char* lds, const Params& P) {
    const int b = blockIdx.x, G = gridDim.x;
    for (int k = 0; k < 16; ++k) {
        int it = -1;
        if (G == 256) {
            if (b < 64) it = k == 0 ? b : (k == 1 ? 64 + b : -1);
            else { const int s = 64 + (b - 64) + 192 * k; it = s < 512 ? 64 + s : -1; }
        } else { it = b + G * k; if (it >= 576) it = -1; }
        if (it < 0) break;
        int seq, rest;
        if (it < 64) { seq = 16 + (it >> 5); rest = it & 31; } else { seq = (it - 64) >> 5; rest = (it - 64) & 31; }
        gla_item(lds, P, seq, rest >> 3, (rest >> 2) & 1, rest & 3);
    }
}

constexpr int BM = 256, BK = 64, HALF = 128, HTB = HALF * BK * 2, NXCD = 8, WGM = 8;
__device__ __forceinline__ int lds_byte(int r, int c) { const int st = (r >> 4) * 2 + (c >> 5), rr = r & 15, cc = c & 31, ob = rr * 64 + cc * 2; return st * 1024 + (ob ^ (((ob >> 9) & 1) << 5)); }
__device__ __forceinline__ void stage_rc(int b, int& R, int& C) { const int st = b / 1024, sb = b % 1024, swz = sb ^ (((sb >> 9) & 1) << 5); R = (st >> 1) * 16 + swz / 64; C = (st & 1) * 32 + (swz % 64) / 2; }
__device__ __forceinline__ int perm32(int rho) { const int n = rho >> 4, i = rho & 15; return 8 * (i >> 2) + 4 * n + (i & 3); }

enum { T_G1 = 0, T_G1B, T_G2, T_G3, T_G4, T_GU, T_DN };

template <int TY>
__device__ __forceinline__ bool unit_next(int i, int bid, int& pm, int& pn) {
    constexpr int nM = (TY == T_GU || TY == T_DN) ? 160 : 320;
    constexpr int nN = TY == T_G1 ? 21 : TY == T_G1B ? 12 : TY == T_GU ? 22 : 4;
    constexpr int nwg = nM * nN;
    const long L = (long)i * gridDim.x + bid;
    if (L >= nwg) return false;
    int wgid = (int)L;
    { const int q = nwg / NXCD, r = nwg % NXCD, xcd = wgid % NXCD, off = wgid / NXCD; wgid = (xcd < r ? xcd * (q + 1) : r * (q + 1) + (xcd - r) * q) + off; }
    const int nig = WGM * nN, gid = wgid / nig, fm = gid * WGM, gsz = (nM - fm) < WGM ? (nM - fm) : WGM;
    pm = fm + ((wgid % nig) % gsz); pn = (wgid % nig) / gsz;
    return true;
}

template <int TY>
__device__ __forceinline__ void gemm_epilogue(const f32x4 (&acc)[2][2][4][2], const Params& P, int batch, int pm, int pn, int wr, int wc, int fr, int fq) {
    const int row0 = pm * 256 + wr * 64 + fr;
    const int cl0 = wc * 32 + 8 * fq;
    if constexpr (TY == T_G1) {
        if (pn < 12) {
            bf16_t* base = (bf16_t*)(P.ws + WS_S1 + (size_t)(pn >> 2) * U) + (pn & 3) * 256 + cl0;
#pragma unroll
            for (int ai = 0; ai < 2; ++ai)
#pragma unroll
                for (int m = 0; m < 4; ++m)
#pragma unroll
                    for (int bj = 0; bj < 2; ++bj) {
                        const f32x4 v0 = acc[ai][bj][m][0], v1 = acc[ai][bj][m][1];
                        *(u32x4*)(base + (size_t)(row0 + ai * 128 + m * 16) * DM + bj * 128) = (u32x4){pk_bf16(v0[0], v0[1]), pk_bf16(v0[2], v0[3]), pk_bf16(v1[0], v1[1]), pk_bf16(v1[2], v1[3])};
                    }
        } else if (pn == 12) {
            if (wc == 0) {
                float* LR = (float*)(P.ws + WS_LR);
#pragma unroll
                for (int ai = 0; ai < 2; ++ai)
#pragma unroll
                    for (int m = 0; m < 4; ++m) {
                        float* d = LR + (size_t)(row0 + ai * 128 + m * 16) * 32 + 8 * fq;
                        *(f32x4*)d = acc[ai][0][m][0]; *(f32x4*)(d + 4) = acc[ai][0][m][1];
                    }
            }
        } else {
            bf16_t* base = (bf16_t*)(P.ws + WS_S4) + (pn - 13) * 128 + cl0;
#pragma unroll
            for (int ai = 0; ai < 2; ++ai)
#pragma unroll
                for (int m = 0; m < 4; ++m) {
                    const f32x4 v0 = acc[ai][0][m][0] * acc[ai][1][m][0], v1 = acc[ai][0][m][1] * acc[ai][1][m][1];
                    *(u32x4*)(base + (size_t)(row0 + ai * 128 + m * 16) * DM) = (u32x4){pk_bf16(v0[0], v0[1]), pk_bf16(v0[2], v0[3]), pk_bf16(v1[0], v1[1]), pk_bf16(v1[2], v1[3])};
                }
        }
    } else if constexpr (TY == T_G1B) {
        if (pn < 4) {
            const bf16_t* XC = (const bf16_t*)(P.ws + WS_S4);
            bf16_t* OBp = (bf16_t*)(P.ws + WS_S2);
#pragma unroll
            for (int bj = 0; bj < 2; ++bj)
#pragma unroll
                for (int n = 0; n < 2; ++n) {
                    const int col = pn * 256 + bj * 128 + cl0 + 4 * n;
                    const f32x4 w0 = *(const f32x4*)(P.in[I_CW] + col), w1 = *(const f32x4*)(P.in[I_CW] + 1024 + col), w2 = *(const f32x4*)(P.in[I_CW] + 2048 + col), cb = *(const f32x4*)(P.in[I_CB] + col);
#pragma unroll
                    for (int ai = 0; ai < 2; ++ai)
#pragma unroll
                        for (int m = 0; m < 4; ++m) {
                            const int row = row0 + ai * 128 + m * 16;
                            const int lm = row < T0 ? 4095 : 8191, pos = row & lm;
                            const u32x2 z = {0u, 0u};
                            const u32x2 xm = pos == 0 ? z : *(const u32x2*)(XC + (size_t)(row - 1) * DM + col);
                            const u32x2 x0 = *(const u32x2*)(XC + (size_t)row * DM + col);
                            const u32x2 xp = pos == lm ? z : *(const u32x2*)(XC + (size_t)(row + 1) * DM + col);
                            const f32x4 v = acc[ai][bj][m][n];
                            const float c0 = bf_lo(xm[0]) * w0[0] + bf_lo(x0[0]) * w1[0] + bf_lo(xp[0]) * w2[0] + cb[0];
                            const float c1 = bf_hi(xm[0]) * w0[1] + bf_hi(x0[0]) * w1[1] + bf_hi(xp[0]) * w2[1] + cb[1];
                            const float c2 = bf_lo(xm[1]) * w0[2] + bf_lo(x0[1]) * w1[2] + bf_lo(xp[1]) * w2[2] + cb[2];
                            const float c3 = bf_hi(xm[1]) * w0[3] + bf_hi(x0[1]) * w1[3] + bf_hi(xp[1]) * w2[3] + cb[3];
                            *(u32x2*)(OBp + (size_t)row * DM + col) = (u32x2){pk_bf16(v[0] * c0, v[1] * c1), pk_bf16(v[2] * c2, v[3] * c3)};
                        }
                }
        } else {
            bf16_t* base = (bf16_t*)(P.ws + (pn < 8 ? WS_S3 : WS_S5)) + (pn & 3) * 256 + cl0;
#pragma unroll
            for (int ai = 0; ai < 2; ++ai)
#pragma unroll
                for (int m = 0; m < 4; ++m)
#pragma unroll
                    for (int bj = 0; bj < 2; ++bj) {
                        const f32x4 v0 = acc[ai][bj][m][0], v1 = acc[ai][bj][m][1];
                        *(u32x4*)(base + (size_t)(row0 + ai * 128 + m * 16) * DM + bj * 128) =
                            (u32x4){pk_bf16(fast_sigmoid(v0[0]), fast_sigmoid(v0[1])), pk_bf16(fast_sigmoid(v0[2]), fast_sigmoid(v0[3])), pk_bf16(fast_sigmoid(v1[0]), fast_sigmoid(v1[1])), pk_bf16(fast_sigmoid(v1[2]), fast_sigmoid(v1[3]))};
                    }
        }
    } else if constexpr (TY == T_G2 || TY == T_G3) {
        bf16_t* M3 = (bf16_t*)(P.ws + WS_S3) + pn * 256 + cl0;
        bf16_t* M5 = (bf16_t*)(P.ws + WS_S5) + pn * 256 + cl0;
#pragma unroll
        for (int ai = 0; ai < 2; ++ai)
#pragma unroll
            for (int m = 0; m < 4; ++m)
#pragma unroll
                for (int bj = 0; bj < 2; ++bj) {
                    const size_t o = (size_t)(row0 + ai * 128 + m * 16) * DM + bj * 128;
                    const f32x4 v0 = acc[ai][bj][m][0], v1 = acc[ai][bj][m][1];
                    if constexpr (TY == T_G2) {
                        const u32x4 g = *(const u32x4*)(M3 + o);
                        *(u32x4*)(M3 + o) = (u32x4){pk_bf16(v0[0] * bf_lo(g[0]), v0[1] * bf_hi(g[0])), pk_bf16(v0[2] * bf_lo(g[1]), v0[3] * bf_hi(g[1])), pk_bf16(v1[0] * bf_lo(g[2]), v1[1] * bf_hi(g[2])), pk_bf16(v1[2] * bf_lo(g[3]), v1[3] * bf_hi(g[3]))};
                    } else {
                        const u32x4 g = *(const u32x4*)(M5 + o), a = *(const u32x4*)(M3 + o);
                        *(u32x4*)(M5 + o) = (u32x4){pk_bf16(bf_lo(a[0]) + v0[0] * bf_lo(g[0]), bf_hi(a[0]) + v0[1] * bf_hi(g[0])), pk_bf16(bf_lo(a[1]) + v0[2] * bf_lo(g[1]), bf_hi(a[1]) + v0[3] * bf_hi(g[1])),
                                                    pk_bf16(bf_lo(a[2]) + v1[0] * bf_lo(g[2]), bf_hi(a[2]) + v1[1] * bf_hi(g[2])), pk_bf16(bf_lo(a[3]) + v1[2] * bf_lo(g[3]), bf_hi(a[3]) + v1[3] * bf_hi(g[3]))};
                    }
                }
    } else if constexpr (TY == T_G4) {
        const float* MOD = (const float*)(P.ws + WS_MOD);
#pragma unroll
        for (int ai = 0; ai < 2; ++ai)
#pragma unroll
            for (int m = 0; m < 4; ++m) {
                const int row = row0 + ai * 128 + m * 16;
                const float* xr = x_row(P, row);
                const float* g1 = MOD + batch_of_row(row) * 6144 + 2048;
#pragma unroll
                for (int bj = 0; bj < 2; ++bj) {
                    const int col = pn * 256 + bj * 128 + cl0;
#pragma unroll
                    for (int n = 0; n < 2; ++n) {
                        const f32x4 xv = *(const f32x4*)(xr + col + 4 * n), gv = *(const f32x4*)(g1 + col + 4 * n);
                        *(f32x4*)(P.out + (size_t)row * DM + col + 4 * n) = xv + gv * acc[ai][bj][m][n];
                    }
                }
            }
    } else if constexpr (TY == T_GU) {
        bf16_t* Hh = (bf16_t*)(P.ws + WS_H) + pn * 128 + cl0;
#pragma unroll
        for (int ai = 0; ai < 2; ++ai)
#pragma unroll
            for (int m = 0; m < 4; ++m) {
                float h[8];
#pragma unroll
                for (int n = 0; n < 2; ++n)
#pragma unroll
                    for (int j = 0; j < 4; ++j) { const float gt = acc[ai][0][m][n][j]; h[4 * n + j] = gt * fast_sigmoid(gt) * acc[ai][1][m][n][j]; }
                *(u32x4*)(Hh + (size_t)(row0 + ai * 128 + m * 16) * DE) = (u32x4){pk_bf16(h[0], h[1]), pk_bf16(h[2], h[3]), pk_bf16(h[4], h[5]), pk_bf16(h[6], h[7])};
            }
    } else if constexpr (TY == T_DN) {
        const float* GV = (const float*)(P.ws + WS_GVAL) + (size_t)batch * ROWS_B;
        bf16_t* YE = (bf16_t*)(P.ws + WS_YE) + (size_t)batch * ROWS_B * DM + pn * 256 + cl0;
#pragma unroll
        for (int ai = 0; ai < 2; ++ai)
#pragma unroll
            for (int m = 0; m < 4; ++m) {
                const int row = row0 + ai * 128 + m * 16;
                const float g = GV[row];
#pragma unroll
                for (int bj = 0; bj < 2; ++bj) {
                    const f32x4 v0 = acc[ai][bj][m][0] * g, v1 = acc[ai][bj][m][1] * g;
                    *(u32x4*)(YE + (size_t)row * DM + bj * 128) = (u32x4){pk_bf16(v0[0], v0[1]), pk_bf16(v0[2], v0[3]), pk_bf16(v1[0], v1[1]), pk_bf16(v1[2], v1[3])};
                }
            }
    }
}

template <int TY>
__device__ __forceinline__ void gemm_phase(LAS unsigned char* lds, const Params& P, int batch) {
    constexpr int K = TY == T_DN ? DE : DM, nt = K / BK;
    constexpr bool GATHER = TY == T_GU;
    const int tid = otid(), wid = __builtin_amdgcn_readfirstlane(tid >> 6), lane = tid & 63, wr = wid >> 2, wc = wid & 3, fr = lane & 15, fq = lane >> 4;
    const unsigned char* Abase = P.ws + (TY == T_G1 || TY == T_G1B ? WS_S0 : TY == T_G2 ? WS_S1 : TY == T_G3 ? WS_S2 : TY == T_G4 ? WS_S5 : TY == T_GU ? WS_S0 : WS_H);
    const unsigned char* Bbase = P.ws + (TY == T_G1 ? WS_WB1 : TY == T_G1B ? WS_WB1 + (size_t)5376 * 1024 * 2 : TY == T_G2 ? WS_WBA : TY == T_G3 ? WS_WBB : TY == T_G4 ? WS_WBO : TY == T_GU ? WS_WGU : WS_WDN);
    const int* TOK = (const int*)(P.ws + WS_TOKOF) + (size_t)batch * ROWS_B;
    constexpr size_t tstep = (size_t)256 * K * 2, hstepB = (size_t)128 * K * 2, kstep = BK * 2;
    int Rs[2], Cs[2];
    unsigned voffB[2], voffA[2][2], voffAn[2][2];
    constexpr size_t hstepA = GATHER ? 0 : (size_t)128 * K * 2;
#pragma unroll
    for (int i = 0; i < 2; ++i) {
        stage_rc(tid * 16 + i * 8192, Rs[i], Cs[i]);
        const int Rb = (Rs[i] & ~31) + perm32(Rs[i] & 31);
        voffB[i] = (unsigned)(Rb * K + Cs[i]) * 2u;
#pragma unroll
        for (int h = 0; h < 2; ++h) voffA[h][i] = voffAn[h][i] = (unsigned)(Rs[i] * K + Cs[i]) * 2u;
    }
    auto a_ptr = [&](int pm) -> const unsigned char* { return GATHER ? Abase : Abase + (size_t)pm * tstep; };
    auto b_ptr = [&](int pm, int pn) -> const unsigned char* {
        if constexpr (TY == T_GU) return Bbase + (size_t)((batch * 160 + pm) / 40) * 5632 * 1024 * 2 + (size_t)pn * tstep;
        else if constexpr (TY == T_DN) return Bbase + (size_t)((batch * 160 + pm) / 40) * 1024 * DE * 2 + (size_t)pn * tstep;
        else return Bbase + (size_t)pn * tstep;
    };
    auto gather_off = [&](int pm, unsigned (&vo)[2][2]) {
#pragma unroll
        for (int h = 0; h < 2; ++h)
#pragma unroll
            for (int i = 0; i < 2; ++i) vo[h][i] = (unsigned)TOK[pm * 256 + h * 128 + Rs[i]] * 2048u + (unsigned)Cs[i] * 2u;
    };
    const unsigned ldsw = (unsigned)wid * 1024u;
    const int aoff = lds_byte(wr * 64 + fr, fq * 8), boff = lds_byte(wc * 32 + fr, fq * 8);
#define G_SA(b, h) (((b) * 2 + (h)) * HTB)
#define G_SB(b, h) ((4 + (b) * 2 + (h)) * HTB)
#define G_STAGE(bufoff, gbase, v0, v1) do { \
        __builtin_amdgcn_global_load_lds((const unsigned*)((gbase) + (v0)), (LAS unsigned*)(lds + (bufoff) + ldsw), 16, 0, 0); \
        __builtin_amdgcn_global_load_lds((const unsigned*)((gbase) + (v1)), (LAS unsigned*)(lds + (bufoff) + ldsw + 8192), 16, 0, 0); } while (0)
#define G_LDA(dst, b, h) do { _Pragma("unroll") for (int m = 0; m < 4; ++m) _Pragma("unroll") for (int k = 0; k < 2; ++k) dst[m][k] = *(const LAS bf16x8*)(lds + G_SA(b, h) + aoff + m * 2048 + k * 1024); } while (0)
#define G_LDB(dst, b, h) do { _Pragma("unroll") for (int n = 0; n < 2; ++n) _Pragma("unroll") for (int k = 0; k < 2; ++k) dst[n][k] = *(const LAS bf16x8*)(lds + G_SB(b, h) + boff + n * 2048 + k * 1024); } while (0)
#define G_MMA(ai, bj, At, Bt) do { __builtin_amdgcn_s_setprio(1); _Pragma("unroll") for (int m = 0; m < 4; ++m) _Pragma("unroll") for (int n = 0; n < 2; ++n) _Pragma("unroll") for (int k = 0; k < 2; ++k) \
        acc[ai][bj][m][n] = __builtin_amdgcn_mfma_f32_16x16x32_bf16(Bt[n][k], At[m][k], acc[ai][bj][m][n], 0, 0, 0); __builtin_amdgcn_s_setprio(0); } while (0)
#define G_WAIT_V(n) asm volatile("s_waitcnt vmcnt(" #n ")" ::: "memory")
#define G_WAIT_L(n) asm volatile("s_waitcnt lgkmcnt(" #n ")" ::: "memory")
#define G_BAR __builtin_amdgcn_s_barrier()
#define G_SCHED __builtin_amdgcn_sched_barrier(0)
    int cpm, cpn, npm = 0, npn = 0, ui = 0;
    int bid = blockIdx.x; asm volatile("" : "+v"(bid)); bid = __builtin_amdgcn_readfirstlane(bid);
    if (!unit_next<TY>(0, bid, cpm, cpn)) return;
    f32x4 acc[2][2][4][2];
#pragma unroll
    for (int a = 0; a < 2; ++a)
#pragma unroll
        for (int b = 0; b < 2; ++b)
#pragma unroll
            for (int m = 0; m < 4; ++m)
#pragma unroll
                for (int n = 0; n < 2; ++n) acc[a][b][m][n] = (f32x4){0.f, 0.f, 0.f, 0.f};
    bf16x8 At[4][2], B0[2][2], B1[2][2];
    const unsigned char* cA = a_ptr(cpm);
    const unsigned char* cB = b_ptr(cpm, cpn);
    if constexpr (GATHER) gather_off(cpm, voffA);
    G_STAGE(G_SB(0, 0), cB, voffB[0], voffB[1]); G_STAGE(G_SA(0, 0), cA, voffA[0][0], voffA[0][1]);
    G_STAGE(G_SB(0, 1), cB + hstepB, voffB[0], voffB[1]); G_STAGE(G_SA(0, 1), cA + hstepA, voffA[1][0], voffA[1][1]);
    if (wr == 1) G_BAR;
    G_WAIT_V(4); G_BAR;
    G_STAGE(G_SB(1, 0), cB + kstep, voffB[0], voffB[1]); G_STAGE(G_SA(1, 0), cA + kstep, voffA[0][0], voffA[0][1]); G_STAGE(G_SB(1, 1), cB + hstepB + kstep, voffB[0], voffB[1]);
    G_WAIT_V(6); G_BAR;
    for (;;) {
        const bool has_next = unit_next<TY>(ui + 1, bid, npm, npn);
        const unsigned char* nA = has_next ? a_ptr(npm) : cA;
        const unsigned char* nB = has_next ? b_ptr(npm, npn) : cB;
        if constexpr (GATHER) {
            if (has_next) gather_off(npm, voffAn);
            else {
#pragma unroll
                for (int h = 0; h < 2; ++h)
#pragma unroll
                    for (int i = 0; i < 2; ++i) voffAn[h][i] = voffA[h][i];
            }
        }
        for (int t = 0; t < nt; t += 2) {
            const bool last = (t == nt - 2);
            const unsigned char* a1 = cA + (size_t)(t + 1) * kstep;
            const unsigned char* a2 = last ? nA : cA + (size_t)(t + 2) * kstep;
            const unsigned char* b2 = last ? nB : cB + (size_t)(t + 2) * kstep;
            const unsigned char* a3 = a2 + kstep;
            const unsigned char* b3 = b2 + kstep;
            unsigned va00 = voffA[0][0], va01 = voffA[0][1], va10 = voffA[1][0], va11 = voffA[1][1];
            if constexpr (GATHER) { if (last) { va00 = voffAn[0][0]; va01 = voffAn[0][1]; va10 = voffAn[1][0]; va11 = voffAn[1][1]; } }
            G_LDB(B0, 0, 0); G_SCHED; G_LDA(At, 0, 0); G_STAGE(G_SA(1, 1), a1 + hstepA, voffA[1][0], voffA[1][1]);
            G_WAIT_L(8); G_BAR; G_WAIT_L(0); G_MMA(0, 0, At, B0); G_BAR; G_SCHED;
            G_LDB(B1, 0, 1); G_STAGE(G_SB(0, 0), b2, voffB[0], voffB[1]);
            G_BAR; G_WAIT_L(0); G_MMA(0, 1, At, B1); G_BAR;
            G_LDA(At, 0, 1); G_STAGE(G_SA(0, 0), a2, va00, va01);
            G_BAR; G_WAIT_L(0); G_MMA(1, 0, At, B0); G_BAR; G_SCHED;
            G_STAGE(G_SB(0, 1), b2 + hstepB, voffB[0], voffB[1]);
            G_WAIT_V(6); G_BAR; G_MMA(1, 1, At, B1); G_BAR;
            G_LDB(B0, 1, 0); G_SCHED; G_LDA(At, 1, 0); G_STAGE(G_SA(0, 1), a2 + hstepA, va10, va11);
            G_WAIT_L(8); G_BAR; G_WAIT_L(0); G_MMA(0, 0, At, B0); G_BAR; G_SCHED;
            G_LDB(B1, 1, 1); G_STAGE(G_SB(1, 0), b3, voffB[0], voffB[1]);
            G_BAR; G_WAIT_L(0); G_MMA(0, 1, At, B1); G_BAR;
            G_LDA(At, 1, 1); G_STAGE(G_SA(1, 0), a3, va00, va01);
            G_BAR; G_WAIT_L(0); G_MMA(1, 0, At, B0); G_BAR; G_SCHED;
            G_STAGE(G_SB(1, 1), b3 + hstepB, voffB[0], voffB[1]);
            G_WAIT_V(6); G_BAR; G_MMA(1, 1, At, B1); G_BAR;
        }
        gemm_epilogue<TY>(acc, P, batch, cpm, cpn, wr, wc, fr, fq);
        if (!has_next) break;
#pragma unroll
        for (int a = 0; a < 2; ++a)
#pragma unroll
            for (int b = 0; b < 2; ++b)
#pragma unroll
                for (int m = 0; m < 4; ++m)
#pragma unroll
                    for (int n = 0; n < 2; ++n) acc[a][b][m][n] = (f32x4){0.f, 0.f, 0.f, 0.f};
        cpm = npm; cpn = npn; cA = nA; cB = nB; ++ui;
        if constexpr (GATHER) {
#pragma unroll
            for (int h = 0; h < 2; ++h)
#pragma unroll
                for (int i = 0; i < 2; ++i) voffA[h][i] = voffAn[h][i];
        }
    }
    G_WAIT_V(0);
    if (wr == 0) G_BAR;
    G_BAR;
#undef G_SA
#undef G_SB
#undef G_STAGE
#undef G_LDA
#undef G_LDB
#undef G_MMA
#undef G_WAIT_V
#undef G_WAIT_L
#undef G_BAR
#undef G_SCHED
}

#ifndef DBG_MASK
#define DBG_MASK 0
#endif
__device__ void phase_dbg(const Params& P) {
    const int tid = otid();
    for (size_t i = (size_t)blockIdx.x * NTHREADS + tid; i < (size_t)NT * DM; i += (size_t)gridDim.x * NTHREADS) {
        float a = 0.f;
        for (int k = 0; k < 6; ++k) if ((DBG_MASK >> k) & 1) a += bf_lo(((const bf16_t*)(P.ws + (size_t)k * U))[i]);
        if ((DBG_MASK >> 6) & 1) a += ((const float*)(P.ws + WS_LR))[(i >> 10) * 32 + (i & 31)];
        P.out[i] = a;
    }
}

constexpr int N_PHASES = 21;
__global__ void __launch_bounds__(NTHREADS) mega_fwd(Params P) {
    extern __shared__ __attribute__((aligned(16))) unsigned char lds_raw[];
    LAS unsigned char* lds = (LAS unsigned char*)lds_raw;
#ifndef PM
#endif
#define PHASE(n, ...) if (((PM >> (n)) & 1) && P.ph_lo <= (n) && (n) < P.ph_hi) { __VA_ARGS__; if ((n) + 1 < P.ph_hi && P.coop) cg::this_grid().sync(); }
    PHASE(0, phase_mod(lds, P); phase_convert_mixer(lds, P))
    PHASE(1, phase_norm1(P))
    PHASE(2, gemm_phase<T_G1>(lds, P, 0))
    PHASE(3, phase_gla(lds, P))
    PHASE(4, phase_oaprep(P))
    PHASE(5, gemm_phase<T_G1B>(lds, P, 0))
    PHASE(6, gemm_phase<T_G2>(lds, P, 0))
    PHASE(7, gemm_phase<T_G3>(lds, P, 0))
    PHASE(8, gemm_phase<T_G4>(lds, P, 0))
    PHASE(9, phase_norm2(lds, P))
    PHASE(10, if (blockIdx.x < 32) phase_topk_item(lds, P, blockIdx.x); else convert_moe(lds, P, blockIdx.x - 32, gridDim.x - 32))
    for (int b = 0; b < 4; ++b) {
        if (((PM >> 11) & 1) && P.ph_lo <= 11 + 2 * b && 11 + 2 * b < P.ph_hi) { gemm_phase<T_GU>(lds, P, b); if (P.coop) cg::this_grid().sync(); }
        if (((PM >> 12) & 1) && P.ph_lo <= 12 + 2 * b && 12 + 2 * b < P.ph_hi) { gemm_phase<T_DN>(lds, P, b); if (P.coop) cg::this_grid().sync(); }
    }
    PHASE(19, phase_final(P))
    if (DBG_MASK && P.ph_lo <= 20 && 20 < P.ph_hi) phase_dbg(P);
}

extern "C" void kernel_launch(void* const* d_in, const int* in_sizes, int n_in, void* d_out, int out_size, void* d_ws, size_t ws_size, hipStream_t stream) {
    static int grid = 0;
    if (grid == 0) {
        int dev = 0, cus = 0, per_cu = 0;
        hipGetDevice(&dev);
        hipDeviceGetAttribute(&cus, hipDeviceAttributeMultiprocessorCount, dev);
        hipFuncSetAttribute((const void*)mega_fwd, hipFuncAttributeMaxDynamicSharedMemorySize, LDS_BYTES);
        hipOccupancyMaxActiveBlocksPerMultiprocessor(&per_cu, (const void*)mega_fwd, NTHREADS, LDS_BYTES);
        (void)hipGetLastError();
        grid = cus > 0 ? cus : 256;
        if (ws_size < ((size_t)1 << 30)) fprintf(stderr, "kernel_launch: workspace %zu smaller than the 1 GiB map\n", ws_size);
    }
    Params p{};
    for (int i = 0; i < 24; ++i) p.in[i] = (const float*)d_in[i];
    p.out = (float*)d_out; p.ws = (unsigned char*)d_ws;
#if MEGA
    p.ph_lo = 0; p.ph_hi = N_PHASES; p.coop = 1; p.pad = 0;
    void* args[] = {&p};
    hipError_t e = hipLaunchCooperativeKernel((const void*)mega_fwd, dim3(grid), dim3(NTHREADS), args, LDS_BYTES, stream);
    if (e != hipSuccess) fprintf(stderr, "cooperative launch failed: %s (grid %d)\n", hipGetErrorString(e), grid);
#else
    for (int ph = 0; ph < N_PHASES; ++ph) {
        p.ph_lo = ph; p.ph_hi = ph + 1; p.coop = 0; p.pad = 0;
        hipLaunchKernelGGL(mega_fwd, dim3(grid), dim3(NTHREADS), LDS_BYTES, stream, p);
    }
#endif
}
```

```cpp
#include <hip/hip_runtime.h>
#include <hip/hip_cooperative_groups.h>
#include <cstdio>
namespace cg = cooperative_groups;

#ifndef PM
#define PM 0xFFFFF
#endif
#ifndef DBG_MASK
#define DBG_MASK 0
#endif
#define DUP 0
#ifndef MEGA
#define MEGA 1
#endif

#define LAS __attribute__((address_space(3)))
typedef unsigned short bf16_t;
typedef short bf16x8 __attribute__((ext_vector_type(8)));
typedef float f32x2 __attribute__((ext_vector_type(2)));
typedef float f32x4 __attribute__((ext_vector_type(4)));
typedef float f32x16 __attribute__((ext_vector_type(16)));
typedef unsigned u32x2 __attribute__((ext_vector_type(2)));
typedef unsigned u32x4 __attribute__((ext_vector_type(4)));

constexpr int NT = 81920;
constexpr int T0 = 65536;
constexpr int DM = 1024;
constexpr int DIN = 8224;
constexpr int NE = 16;
constexpr int DE = 2816;
constexpr int ROWS_E = 10240;
constexpr int ROWS_B = 40960;
constexpr float EPS = 1e-6f;
constexpr int LDS_BYTES = 131072;
constexpr int NTHREADS = 512;

constexpr size_t U = (size_t)NT * DM * 2;
constexpr size_t WS_S0 = 0, WS_S1 = U, WS_S2 = 2 * U, WS_S3 = 3 * U, WS_S4 = 4 * U, WS_S5 = 5 * U;
constexpr size_t WS_WB1 = 6 * U;
constexpr size_t WS_WBA = WS_WB1 + (size_t)8448 * 1024 * 2;
constexpr size_t WS_WBB = WS_WBA + (size_t)1024 * 1024 * 2;
constexpr size_t WS_WBO = WS_WBB + (size_t)1024 * 1024 * 2;
constexpr size_t WS_LR = WS_WBO + (size_t)1024 * 1024 * 2;
constexpr size_t WS_TAIL = ((size_t)1 << 30) - ((size_t)16 << 20);
constexpr size_t WS_MOD = WS_TAIL;
constexpr size_t WS_AFFT = WS_TAIL + ((size_t)512 << 10);
constexpr size_t WS_TOKOF = WS_AFFT + ((size_t)5 << 20);
constexpr size_t WS_GVAL = WS_TOKOF + ((size_t)640 << 10);
constexpr size_t WS_SLOTOF = WS_GVAL + ((size_t)640 << 10);
constexpr size_t WS_WGU = U;
constexpr size_t WS_WDN = WS_WGU + (size_t)16 * 5632 * 1024 * 2;
constexpr size_t WS_H = WS_WDN + (size_t)16 * 1024 * 2816 * 2;
constexpr size_t WS_YE = WS_H + (size_t)ROWS_B * DE * 2;
static_assert(WS_LR + (size_t)NT * 32 * 4 <= WS_TAIL, "ws map");
static_assert(WS_YE + 2 * U <= WS_TAIL, "ws map");
static_assert(WS_SLOTOF + (size_t)NT * 16 * 4 <= ((size_t)1 << 30), "ws map");

struct Params {
    const float* in[24];
    float* out;
    unsigned char* ws;
    int ph_lo, ph_hi, coop, pad;
};
enum { I_XP = 0, I_XS, I_CP, I_CS, I_WADA, I_BADA, I_N1W, I_WIN, I_WAF, I_BAF, I_WAB, I_BAB, I_GNW, I_CW, I_CB, I_WOA, I_WOB, I_WO, I_N2W, I_WR, I_WG, I_WU, I_WD, I_NFW };

typedef __bf16 bf16x2_t __attribute__((ext_vector_type(2)));
__device__ __forceinline__ unsigned pk_bf16(float lo, float hi) { bf16x2_t v = {(__bf16)lo, (__bf16)hi}; return __builtin_bit_cast(unsigned, v); }
__device__ __forceinline__ float bf_lo(unsigned w) { return __uint_as_float(w << 16); }
__device__ __forceinline__ float bf_hi(unsigned w) { return __uint_as_float(w & 0xffff0000u); }
__device__ __forceinline__ float fast_sigmoid(float x) { return __builtin_amdgcn_rcpf(1.0f + __expf(-x)); }
__device__ __forceinline__ float wave_sum(float v) {
#pragma unroll
    for (int m = 32; m >= 1; m >>= 1) v += __shfl_xor(v, m);
    return v;
}
__device__ __forceinline__ int otid() { int t = threadIdx.x; asm volatile("" : "+v"(t)); return t; }
__device__ __forceinline__ int batch_of_row(int row) { return row < T0 ? (row >> 12) : 16 + ((row - T0) >> 13); }
__device__ __forceinline__ const float* x_row(const Params& P, int row) { return row < T0 ? P.in[I_XP] + (size_t)row * DM : P.in[I_XS] + (size_t)(row - T0) * DM; }

__device__ __forceinline__ void phase_mod(LAS unsigned char* lds, const Params& P) {
    LAS float* sc = (LAS float*)lds;
    float* MOD = (float*)(P.ws + WS_MOD);
    const int tid = otid();
    for (int chunk = blockIdx.x; chunk < 18 * 12; chunk += gridDim.x) {
        const int b = chunk / 12, j = (chunk % 12) * 512 + tid;
        const float* c = b < 16 ? P.in[I_CP] + b * DM : P.in[I_CS] + (b - 16) * DM;
        __syncthreads();
        for (int k = tid; k < DM; k += NTHREADS) { float v = c[k]; sc[k] = v / (1.0f + __expf(-v)); }
        __syncthreads();
        const float* w = P.in[I_WADA] + j;
        float a0 = 0.f, a1 = 0.f, a2 = 0.f, a3 = 0.f;
        for (int k = 0; k < DM; k += 4) {
            a0 += sc[k] * w[(size_t)k * 6144];
            a1 += sc[k + 1] * w[(size_t)(k + 1) * 6144];
            a2 += sc[k + 2] * w[(size_t)(k + 2) * 6144];
            a3 += sc[k + 3] * w[(size_t)(k + 3) * 6144];
        }
        MOD[b * 6144 + j] = (a0 + a1) + (a2 + a3) + P.in[I_BADA][j];
    }
    __syncthreads();
}

__device__ __forceinline__ void convert_tile(LAS unsigned char* lds, const float* src, int ld_src, int colA, int colB, float scale, int k0, bf16_t* dst, int ld_dst) {
    LAS float* tile = (LAS float*)lds;
    const int tid = otid();
    {
        const int n = tid & 63, kk = tid >> 6;
        const int col = n < 32 ? (colA < 0 ? -1 : colA + n) : (colB < 0 ? -1 : colB + n - 32);
        const float* s = src + (size_t)(k0 + kk) * ld_src + (col < 0 ? 0 : col);
#pragma unroll
        for (int pass = 0; pass < 16; ++pass) {
            float v = col < 0 ? 0.f : s[(size_t)pass * 8 * ld_src] * scale;
            tile[(pass * 8 + kk) * 65 + n] = v;
        }
    }
    __syncthreads();
    {
        const int n = tid >> 3, ks = tid & 7;
        unsigned w[8];
#pragma unroll
        for (int j = 0; j < 8; ++j) w[j] = pk_bf16(tile[(ks * 16 + 2 * j) * 65 + n], tile[(ks * 16 + 2 * j + 1) * 65 + n]);
        bf16_t* d = dst + (size_t)n * ld_dst + k0 + ks * 16;
        *(u32x4*)d = (u32x4){w[0], w[1], w[2], w[3]};
        *(u32x4*)(d + 8) = (u32x4){w[4], w[5], w[6], w[7]};
    }
    __syncthreads();
}

__device__ __forceinline__ int win_col(int n) {
    if (n < 3072) return n;
    if (n < 3328) { int j = n - 3072; return j < 32 ? 3072 + j : -1; }
    if (n < 5376) { int j = n - 3328, b = j >> 8, w = j & 255; return (w < 128 ? 4128 : 5152) + b * 128 + (w & 127); }
    if (n < 6400) return 3104 + (n - 5376);
    return 6176 + (n - 6400);
}

__device__ __forceinline__ void phase_convert_mixer(LAS unsigned char* lds, const Params& P) {
    for (int t = blockIdx.x; t < 1056 + 384; t += gridDim.x) {
        if (t < 1056) {
            const int rt = t >> 3, kt = t & 7, n0 = rt * 64;
            convert_tile(lds, P.in[I_WIN], DIN, win_col(n0), win_col(n0 + 32), n0 < 512 ? 0.08838834764831845f : 1.0f, kt * 128,
                         (bf16_t*)(P.ws + WS_WB1) + (size_t)n0 * 1024, 1024);
        } else {
            const int u = t - 1056, which = u >> 7, rt = (u & 127) >> 3, kt = u & 7, n0 = rt * 64;
            const float* src = P.in[which == 0 ? I_WOA : which == 1 ? I_WOB : I_WO];
            bf16_t* dst = (bf16_t*)(P.ws + (which == 0 ? WS_WBA : which == 1 ? WS_WBB : WS_WBO));
            convert_tile(lds, src, 1024, n0, n0 + 32, 1.0f, kt * 128, dst + (size_t)n0 * 1024, 1024);
        }
    }
}

constexpr size_t WS_CNT = WS_MOD + ((size_t)480 << 10);
struct ConvDesc { const float* src; bf16_t* dst; int ld_src, ld_dst, col, k0; };
__device__ __forceinline__ ConvDesc moe_tile_desc(const Params& P, int t) {
    ConvDesc d;
    const int e = t / 1056, r = t % 1056;
    if (r < 704) {
        const int rt = r >> 3, kt = r & 7, n0 = rt * 64, blk = n0 >> 8, w = n0 & 255;
        d.src = (w < 128 ? P.in[I_WG] : P.in[I_WU]) + (size_t)e * 1024 * DE; d.ld_src = DE; d.col = blk * 128 + (w & 127); d.k0 = kt * 128;
        d.dst = (bf16_t*)(P.ws + WS_WGU) + ((size_t)e * 5632 + n0) * 1024; d.ld_dst = 1024;
    } else {
        const int r2 = r - 704, rt = r2 / 22, kt = r2 % 22, n0 = rt * 64;
        d.src = P.in[I_WD] + (size_t)e * DE * 1024; d.ld_src = 1024; d.col = n0; d.k0 = kt * 128;
        d.dst = (bf16_t*)(P.ws + WS_WDN) + ((size_t)e * 1024 + n0) * DE; d.ld_dst = DE;
    }
    return d;
}
struct ConvRegs { float v[16]; };
__device__ __forceinline__ void conv_load(ConvRegs& R, const ConvDesc& d, int tid) {
    const int n = tid & 63, kk = tid >> 6;
    const float* s = d.src + (size_t)(d.k0 + kk) * d.ld_src + d.col + n;
#pragma unroll
    for (int pass = 0; pass < 16; ++pass) R.v[pass] = s[(size_t)pass * 8 * d.ld_src];
}
__device__ __forceinline__ void conv_store(LAS unsigned char* lds, const ConvRegs& R, const ConvDesc& d, int tid) {
    LAS float* tile = (LAS float*)lds;
    {
        const int n = tid & 63, kk = tid >> 6;
#pragma unroll
        for (int pass = 0; pass < 16; ++pass) tile[(pass * 8 + kk) * 65 + n] = R.v[pass];
    }
    __syncthreads();
    {
        const int n = tid >> 3, ks = tid & 7;
        unsigned w[8];
#pragma unroll
        for (int j = 0; j < 8; ++j) w[j] = pk_bf16(tile[(ks * 16 + 2 * j) * 65 + n], tile[(ks * 16 + 2 * j + 1) * 65 + n]);
        bf16_t* o = d.dst + (size_t)n * d.ld_dst + d.k0 + ks * 16;
        *(u32x4*)o = (u32x4){w[0], w[1], w[2], w[3]};
        *(u32x4*)(o + 8) = (u32x4){w[4], w[5], w[6], w[7]};
    }
    __syncthreads();
}
__device__ __forceinline__ void convert_moe(LAS unsigned char* lds, const Params& P) {
    constexpr int TOTAL = 16 * 1056, BATCH = 8;
    static_assert(TOTAL % BATCH == 0, "batch");
    const int tid = otid();
    unsigned* cnt = (unsigned*)(P.ws + WS_CNT);
    LAS int* bc = (LAS int*)(lds + 40960);
    __syncthreads();
    if (tid == 0) { bc[0] = (int)atomicAdd(cnt, (unsigned)BATCH); bc[1] = (int)atomicAdd(cnt, (unsigned)BATCH); }
    __syncthreads();
    int tb_cur = bc[0], tb_nxt = bc[1], pos = 0;
    __syncthreads();
    if (tb_cur >= TOTAL) return;
    ConvRegs R, Rn;
    ConvDesc d = moe_tile_desc(P, tb_cur), dn = d;
    conv_load(R, d, tid);
    for (;;) {
        const bool newbatch = (pos + 1 == BATCH);
        const int tn = newbatch ? tb_nxt : tb_cur + pos + 1;
        const bool has = tn < TOTAL;
        if (newbatch && tid == 0) bc[0] = (int)atomicAdd(cnt, (unsigned)BATCH);
        if (has) { dn = moe_tile_desc(P, tn); conv_load(Rn, dn, tid); }
        conv_store(lds, R, d, tid);
        if (!has) break;
        if (newbatch) { tb_cur = tb_nxt; tb_nxt = bc[0]; pos = 0; } else ++pos;
        R = Rn; d = dn;
    }
    __syncthreads();
}

__device__ __forceinline__ void phase_norm1(const Params& P) {
    const int tid_ = otid();
    const int lane = tid_ & 63, gw = blockIdx.x * 8 + (tid_ >> 6), nw = gridDim.x * 8;
    const int per = (NT + nw - 1) / nw;
    const int r_lo = gw * per, r_hi = min(NT, r_lo + per);
    const float* MOD = (const float*)(P.ws + WS_MOD);
    bf16_t* Uo = (bf16_t*)(P.ws + WS_S0);
    int curb = -1;
    float A[16], B[16];
    for (int row = r_lo; row < r_hi; ++row) {
        const int b = batch_of_row(row);
        if (b != curb) {
            curb = b;
#pragma unroll
            for (int i = 0; i < 2; ++i)
#pragma unroll
                for (int j = 0; j < 8; ++j) {
                    const int c = 8 * lane + 512 * i + j;
                    A[i * 8 + j] = P.in[I_N1W][c] * (1.0f + MOD[b * 6144 + 1024 + c]);
                    B[i * 8 + j] = MOD[b * 6144 + c];
                }
        }
        const float* xr = x_row(P, row);
        float v[16];
#pragma unroll
        for (int i = 0; i < 2; ++i) {
            const f32x4 a = *(const f32x4*)(xr + 8 * lane + 512 * i), c = *(const f32x4*)(xr + 8 * lane + 512 * i + 4);
            v[i * 8 + 0] = a[0]; v[i * 8 + 1] = a[1]; v[i * 8 + 2] = a[2]; v[i * 8 + 3] = a[3];
            v[i * 8 + 4] = c[0]; v[i * 8 + 5] = c[1]; v[i * 8 + 6] = c[2]; v[i * 8 + 7] = c[3];
        }
        float ss = 0.f;
#pragma unroll
        for (int j = 0; j < 16; ++j) ss += v[j] * v[j];
        ss = wave_sum(ss);
        const float rstd = rsqrtf(ss * (1.0f / 1024.0f) + EPS);
#pragma unroll
        for (int i = 0; i < 2; ++i) {
            unsigned w[4];
#pragma unroll
            for (int j = 0; j < 4; ++j) w[j] = pk_bf16(v[i * 8 + 2 * j] * rstd * A[i * 8 + 2 * j] + B[i * 8 + 2 * j], v[i * 8 + 2 * j + 1] * rstd * A[i * 8 + 2 * j + 1] + B[i * 8 + 2 * j + 1]);
            *(u32x4*)(Uo + (size_t)row * DM + 8 * lane + 512 * i) = (u32x4){w[0], w[1], w[2], w[3]};
        }
    }
}

__device__ __forceinline__ void phase_oaprep(const Params& P) {
    const int tid_ = otid();
    const int lane = tid_ & 63, gw = blockIdx.x * 8 + (tid_ >> 6), nw = gridDim.x * 8;
    const bf16_t* OF = (const bf16_t*)P.out;
    const bf16_t* OB = OF + (size_t)NT * DM;
    const bf16_t* R = (const bf16_t*)(P.ws + WS_S3);
    bf16_t* OA = (bf16_t*)(P.ws + WS_S1);
    float g[16];
#pragma unroll
    for (int j = 0; j < 16; ++j) g[j] = P.in[I_GNW][16 * lane + j];
    for (int row = gw; row < NT; row += nw) {
        const size_t off = (size_t)row * DM + 16 * lane;
        const u32x4 f0 = *(const u32x4*)(OF + off), f1 = *(const u32x4*)(OF + off + 8);
        const u32x4 b0 = *(const u32x4*)(OB + off), b1 = *(const u32x4*)(OB + off + 8);
        const u32x4 r0 = *(const u32x4*)(R + off), r1 = *(const u32x4*)(R + off + 8);
        float o[16], rr[16];
#pragma unroll
        for (int j = 0; j < 4; ++j) {
            o[2 * j] = bf_lo(f0[j]) + bf_lo(b0[j]); o[2 * j + 1] = bf_hi(f0[j]) + bf_hi(b0[j]);
            o[8 + 2 * j] = bf_lo(f1[j]) + bf_lo(b1[j]); o[8 + 2 * j + 1] = bf_hi(f1[j]) + bf_hi(b1[j]);
            rr[2 * j] = bf_lo(r0[j]); rr[2 * j + 1] = bf_hi(r0[j]); rr[8 + 2 * j] = bf_lo(r1[j]); rr[8 + 2 * j + 1] = bf_hi(r1[j]);
        }
        float ss = 0.f;
#pragma unroll
        for (int j = 0; j < 16; ++j) ss += o[j] * o[j];
        ss += __shfl_xor(ss, 1); ss += __shfl_xor(ss, 2); ss += __shfl_xor(ss, 4); ss += __shfl_xor(ss, 8);
        const float rstd = rsqrtf(ss * (1.0f / 256.0f) + EPS);
        unsigned w[8];
#pragma unroll
        for (int j = 0; j < 8; ++j) {
            const float a = o[2 * j] * rstd * g[2 * j] * (rr[2 * j] * fast_sigmoid(rr[2 * j]));
            const float c = o[2 * j + 1] * rstd * g[2 * j + 1] * (rr[2 * j + 1] * fast_sigmoid(rr[2 * j + 1]));
            w[j] = pk_bf16(a, c);
        }
        *(u32x4*)(OA + off) = (u32x4){w[0], w[1], w[2], w[3]};
        *(u32x4*)(OA + off + 8) = (u32x4){w[4], w[5], w[6], w[7]};
    }
}

__device__ __forceinline__ void phase_norm2(LAS unsigned char* lds, const Params& P) {
    LAS float* wrT = (LAS float*)lds;
    const int tid = otid();
    for (int i = tid; i < DM * NE; i += NTHREADS) wrT[(i & 15) * 1024 + (i >> 4)] = P.in[I_WR][i];
    __syncthreads();
    const int lane = tid & 63, gw = blockIdx.x * 8 + (tid >> 6), nw = gridDim.x * 8;
    const int per = (NT + nw - 1) / nw;
    const int r_lo = gw * per, r_hi = min(NT, r_lo + per);
    const float* MOD = (const float*)(P.ws + WS_MOD);
    const float* X1 = P.out;
    bf16_t* Uo = (bf16_t*)(P.ws + WS_S0);
    float* AFFT = (float*)(P.ws + WS_AFFT);
    int curb = -1;
    float A[16], B[16];
    for (int row = r_lo; row < r_hi; ++row) {
        const int b = batch_of_row(row);
        if (b != curb) {
            curb = b;
#pragma unroll
            for (int i = 0; i < 2; ++i)
#pragma unroll
                for (int j = 0; j < 8; ++j) {
                    const int c = 8 * lane + 512 * i + j;
                    A[i * 8 + j] = P.in[I_N2W][c] * (1.0f + MOD[b * 6144 + 4096 + c]);
                    B[i * 8 + j] = MOD[b * 6144 + 3072 + c];
                }
        }
        const float* xr = X1 + (size_t)row * DM;
        float v[16];
#pragma unroll
        for (int i = 0; i < 2; ++i) {
            const f32x4 a = *(const f32x4*)(xr + 8 * lane + 512 * i), c = *(const f32x4*)(xr + 8 * lane + 512 * i + 4);
            v[i * 8 + 0] = a[0]; v[i * 8 + 1] = a[1]; v[i * 8 + 2] = a[2]; v[i * 8 + 3] = a[3];
            v[i * 8 + 4] = c[0]; v[i * 8 + 5] = c[1]; v[i * 8 + 6] = c[2]; v[i * 8 + 7] = c[3];
        }
        float ss = 0.f;
#pragma unroll
        for (int j = 0; j < 16; ++j) ss += v[j] * v[j];
        ss = wave_sum(ss);
        const float rstd = rsqrtf(ss * (1.0f / 1024.0f) + EPS);
#pragma unroll
        for (int j = 0; j < 16; ++j) v[j] = v[j] * rstd * A[j] + B[j];
#pragma unroll
        for (int i = 0; i < 2; ++i) {
            unsigned w[4];
#pragma unroll
            for (int j = 0; j < 4; ++j) w[j] = pk_bf16(v[i * 8 + 2 * j], v[i * 8 + 2 * j + 1]);
            *(u32x4*)(Uo + (size_t)row * DM + 8 * lane + 512 * i) = (u32x4){w[0], w[1], w[2], w[3]};
        }
        int wo = 0; asm volatile("" : "+v"(wo));
        const LAS float* wrTo = wrT + wo;
        float lg[16];
#pragma unroll
        for (int e = 0; e < 16; ++e) {
            float s = 0.f;
#pragma unroll
            for (int i = 0; i < 2; ++i) {
                const f32x4 w0 = *(const LAS f32x4*)(wrTo + e * 1024 + 8 * lane + 512 * i), w1 = *(const LAS f32x4*)(wrTo + e * 1024 + 8 * lane + 512 * i + 4);
                s += v[i * 8 + 0] * w0[0] + v[i * 8 + 1] * w0[1] + v[i * 8 + 2] * w0[2] + v[i * 8 + 3] * w0[3];
                s += v[i * 8 + 4] * w1[0] + v[i * 8 + 5] * w1[1] + v[i * 8 + 6] * w1[2] + v[i * 8 + 7] * w1[3];
            }
            lg[e] = s;
        }
        float t8[8], t4[4], t2[2], t1;
        {
            const bool hi = lane & 1;
#pragma unroll
            for (int i = 0; i < 8; ++i) { const float keep = hi ? lg[2 * i + 1] : lg[2 * i], send = hi ? lg[2 * i] : lg[2 * i + 1]; t8[i] = keep + __shfl_xor(send, 1); }
        }
        {
            const bool hi = lane & 2;
#pragma unroll
            for (int i = 0; i < 4; ++i) { const float keep = hi ? t8[2 * i + 1] : t8[2 * i], send = hi ? t8[2 * i] : t8[2 * i + 1]; t4[i] = keep + __shfl_xor(send, 2); }
        }
        {
            const bool hi = lane & 4;
#pragma unroll
            for (int i = 0; i < 2; ++i) { const float keep = hi ? t4[2 * i + 1] : t4[2 * i], send = hi ? t4[2 * i] : t4[2 * i + 1]; t2[i] = keep + __shfl_xor(send, 4); }
        }
        {
            const bool hi = lane & 8;
            const float keep = hi ? t2[1] : t2[0], send = hi ? t2[0] : t2[1]; t1 = keep + __shfl_xor(send, 8);
        }
        t1 += __shfl_xor(t1, 16); t1 += __shfl_xor(t1, 32);
        float mx = t1;
        mx = fmaxf(mx, __shfl_xor(mx, 1)); mx = fmaxf(mx, __shfl_xor(mx, 2)); mx = fmaxf(mx, __shfl_xor(mx, 4)); mx = fmaxf(mx, __shfl_xor(mx, 8));
        const float ex = expf(t1 - mx);
        float sm = ex;
        sm += __shfl_xor(sm, 1); sm += __shfl_xor(sm, 2); sm += __shfl_xor(sm, 4); sm += __shfl_xor(sm, 8);
        if (lane < 16) AFFT[(size_t)lane * NT + row] = ex / sm;
    }
    __syncthreads();
}

__device__ __forceinline__ int block_suffix_incl(int v, LAS int* scr, int tid) {
    const int lane = tid & 63, wid = tid >> 6;
#pragma unroll
    for (int d = 1; d < 64; d <<= 1) { const int t = __shfl_down(v, d); if (lane + d < 64) v += t; }
    __syncthreads();
    if (lane == 0) scr[wid] = v;
    __syncthreads();
    int add = 0;
#pragma unroll
    for (int w = 0; w < 8; ++w) add += (w > wid) ? scr[w] : 0;
    return v + add;
}
__device__ __forceinline__ int block_prefix_incl(int v, LAS int* scr, int tid) {
    const int lane = tid & 63, wid = tid >> 6;
#pragma unroll
    for (int d = 1; d < 64; d <<= 1) { const int t = __shfl_up(v, d); if (lane >= d) v += t; }
    __syncthreads();
    if (lane == 63) scr[wid] = v;
    __syncthreads();
    int add = 0;
#pragma unroll
    for (int w = 0; w < 8; ++w) add += (w < wid) ? scr[w] : 0;
    return v + add;
}
template <int NB>
__device__ __forceinline__ int block_find_bin(LAS int* hist, LAS int* scr, int k, int& krem, int tid) {
    int loc = 0;
#pragma unroll
    for (int j = 0; j < NB; ++j) loc += hist[tid * NB + j];
    const int suf_incl = block_suffix_incl(loc, scr, tid), suf_excl = suf_incl - loc;
    if (suf_excl < k && suf_incl >= k) {
        int run = suf_excl;
#pragma unroll
        for (int j = NB - 1; j >= 0; --j) {
            const int h = hist[tid * NB + j];
            if (run < k && run + h >= k) { scr[16] = tid * NB + j; scr[17] = k - run; }
            run += h;
        }
    }
    __syncthreads();
    const int bin = scr[16];
    krem = scr[17];
    __syncthreads();
    return bin;
}
__device__ __forceinline__ void lds_inc(LAS int* p) { __hip_atomic_fetch_add(p, 1, __ATOMIC_RELAXED, __HIP_MEMORY_SCOPE_WORKGROUP); }

template <int LEN>
__device__ __forceinline__ void topk_item(LAS unsigned char* lds, const Params& P, int g, int e) {
    LAS int* hist = (LAS int*)lds;
    LAS int* scr = (LAS int*)(lds + 16384);
    const int tid = otid();
    constexpr int T = LEN * NTHREADS;
    const int t0 = g ? T0 : 0, cap = T >> 3, lo = tid * LEN;
    const u32x4* v4 = (const u32x4*)((const unsigned*)(P.ws + WS_AFFT) + (size_t)e * NT + t0 + lo);
#define TOPK_FOREACH(BODY) for (int ib = 0; ib < LEN / 16; ++ib) { u32x4 q_[4]; _Pragma("unroll") for (int u = 0; u < 4; ++u) q_[u] = v4[ib * 4 + u]; \
        _Pragma("unroll") for (int u = 0; u < 4; ++u) _Pragma("unroll") for (int j = 0; j < 4; ++j) { const unsigned x = q_[u][j]; const int idx = ib * 16 + u * 4 + j; (void)idx; BODY } }
    int k = cap, krem;
    for (int i = tid; i < 4096; i += NTHREADS) hist[i] = 0;
    __syncthreads();
    TOPK_FOREACH(lds_inc(&hist[x >> 20]);)
    __syncthreads();
    const unsigned p1 = (unsigned)block_find_bin<8>(hist, scr, k, krem, tid); k = krem;
    for (int i = tid; i < 4096; i += NTHREADS) hist[i] = 0;
    __syncthreads();
    TOPK_FOREACH(if ((x >> 20) == p1) lds_inc(&hist[(x >> 8) & 4095]);)
    __syncthreads();
    const unsigned p2 = (unsigned)block_find_bin<8>(hist, scr, k, krem, tid); k = krem;
    hist[tid] = 0;
    __syncthreads();
    const unsigned p12 = (p1 << 12) | p2;
    TOPK_FOREACH(if ((x >> 8) == p12) lds_inc(&hist[x & 255]);)
    __syncthreads();
    const unsigned p3 = (unsigned)block_find_bin<1>(hist, scr, k, krem, tid);
    const unsigned thr = (p12 << 8) | p3;
    const int keq = krem;
    int cg_ = 0, ce = 0;
    TOPK_FOREACH(cg_ += x > thr; ce += x == thr;)
    int gt_run = block_prefix_incl(cg_, scr, tid) - cg_;
    int eq_run = block_prefix_incl(ce, scr, tid) - ce;
    int* TOKOF = (int*)(P.ws + WS_TOKOF);
    float* GVAL = (float*)(P.ws + WS_GVAL);
    int* SLOTOF = (int*)(P.ws + WS_SLOTOF);
    const int rbase = e * ROWS_E + (g ? 8192 : 0);
    TOPK_FOREACH(
        const bool isg = x > thr; const bool ise = x == thr;
        const bool sel = isg || (ise && eq_run < keq);
        const int slot = gt_run + min(eq_run, keq);
        const int trow = t0 + lo + idx;
        if (sel) { TOKOF[rbase + slot] = trow; GVAL[rbase + slot] = __uint_as_float(x); }
        SLOTOF[(size_t)trow * 16 + e] = sel ? rbase + slot : -1;
        gt_run += isg; eq_run += ise;)
#undef TOPK_FOREACH
    __syncthreads();
}
__device__ __forceinline__ void phase_topk_item(LAS unsigned char* lds, const Params& P, int item) {
    if (item < 16) topk_item<128>(lds, P, 0, item); else topk_item<32>(lds, P, 1, item - 16);
}

__device__ __forceinline__ void phase_final(const Params& P) {
    const int tid_ = otid();
    const int lane = tid_ & 63, gw = blockIdx.x * 8 + (tid_ >> 6), nw = gridDim.x * 8;
    const float* MOD = (const float*)(P.ws + WS_MOD);
    const int* SLOTOF = (const int*)(P.ws + WS_SLOTOF);
    const bf16_t* YE = (const bf16_t*)(P.ws + WS_YE);
    float wf[16];
#pragma unroll
    for (int i = 0; i < 2; ++i)
#pragma unroll
        for (int j = 0; j < 8; ++j) wf[i * 8 + j] = P.in[I_NFW][8 * lane + 512 * i + j];
    for (int row = gw; row < NT; row += nw) {
        const int b = batch_of_row(row);
        float* xr = P.out + (size_t)row * DM;
        float v[16], acc[16];
#pragma unroll
        for (int i = 0; i < 2; ++i) {
            const f32x4 a = *(const f32x4*)(xr + 8 * lane + 512 * i), c = *(const f32x4*)(xr + 8 * lane + 512 * i + 4);
            v[i * 8 + 0] = a[0]; v[i * 8 + 1] = a[1]; v[i * 8 + 2] = a[2]; v[i * 8 + 3] = a[3];
            v[i * 8 + 4] = c[0]; v[i * 8 + 5] = c[1]; v[i * 8 + 6] = c[2]; v[i * 8 + 7] = c[3];
        }
#pragma unroll
        for (int j = 0; j < 16; ++j) acc[j] = 0.f;
        const int myslot = SLOTOF[(size_t)row * 16 + (lane & 15)];
        for (int e = 0; e < 16; ++e) {
            const int s = __shfl(myslot, e);
            if (s >= 0) {
#pragma unroll
                for (int i = 0; i < 2; ++i) {
                    const u32x4 y = *(const u32x4*)(YE + (size_t)s * DM + 8 * lane + 512 * i);
#pragma unroll
                    for (int j = 0; j < 4; ++j) { acc[i * 8 + 2 * j] += bf_lo(y[j]); acc[i * 8 + 2 * j + 1] += bf_hi(y[j]); }
                }
            }
        }
        float ss = 0.f;
#pragma unroll
        for (int i = 0; i < 2; ++i)
#pragma unroll
            for (int j = 0; j < 8; ++j) {
                const float g2 = MOD[b * 6144 + 5120 + 8 * lane + 512 * i + j];
                v[i * 8 + j] += g2 * acc[i * 8 + j];
                ss += v[i * 8 + j] * v[i * 8 + j];
            }
        ss = wave_sum(ss);
        const float rstd = rsqrtf(ss * (1.0f / 1024.0f) + EPS);
#pragma unroll
        for (int i = 0; i < 2; ++i) {
            *(f32x4*)(xr + 8 * lane + 512 * i) = (f32x4){v[i * 8 + 0] * rstd * wf[i * 8 + 0], v[i * 8 + 1] * rstd * wf[i * 8 + 1], v[i * 8 + 2] * rstd * wf[i * 8 + 2], v[i * 8 + 3] * rstd * wf[i * 8 + 3]};
            *(f32x4*)(xr + 8 * lane + 512 * i + 4) = (f32x4){v[i * 8 + 4] * rstd * wf[i * 8 + 4], v[i * 8 + 5] * rstd * wf[i * 8 + 5], v[i * 8 + 6] * rstd * wf[i * 8 + 6], v[i * 8 + 7] * rstd * wf[i * 8 + 7]};
        }
    }
}

__device__ __forceinline__ void phase_glaprep(LAS unsigned char* lds, const Params& P) {
    const int tid = otid();
    const float* LR = (const float*)(P.ws + WS_LR);
    unsigned* EQ = (unsigned*)(P.ws + WS_S5);
    LAS float* lrs = (LAS float*)lds;
    const int dir = tid >> 8, col = 2 * (tid & 255);
    float wa[16][2], bias[2];
    {
        const float* w = P.in[dir ? I_WAB : I_WAF] + col;
#pragma unroll
        for (int r = 0; r < 16; ++r) { const f32x2 t = *(const f32x2*)(w + r * 512); wa[r][0] = t[0]; wa[r][1] = t[1]; }
        const f32x2 t = *(const f32x2*)(P.in[dir ? I_BAB : I_BAF] + col);
        bias[0] = t[0]; bias[1] = t[1];
    }
    for (int ch = blockIdx.x; ch < NT / 64; ch += gridDim.x) {
        const int rc = ch * 64;
        __syncthreads();
        *(LAS f32x4*)(lrs + tid * 4) = *(const f32x4*)(LR + (size_t)rc * 32 + tid * 4);
        __syncthreads();
        float c0 = 0.f, c1 = 0.f;
        for (int ii = 0; ii < 64; ++ii) {
            const int tok = dir ? 63 - ii : ii;
            const LAS f32x4* lp = (const LAS f32x4*)(lrs + tok * 32 + dir * 16);
            float x0 = bias[0], x1 = bias[1];
#pragma unroll
            for (int r4 = 0; r4 < 4; ++r4) {
                const f32x4 l = lp[r4];
#pragma unroll
                for (int r = 0; r < 4; ++r) { x0 += l[r] * wa[r4 * 4 + r][0]; x1 += l[r] * wa[r4 * 4 + r][1]; }
            }
            c0 += (fminf(x0, 0.f) - __logf(1.0f + __expf(-fabsf(x0)))) * 0.0625f;
            c1 += (fminf(x1, 0.f) - __logf(1.0f + __expf(-fabsf(x1)))) * 0.0625f;
            EQ[((size_t)(rc + tok) * 1024 + dir * 512 + col) >> 1] = pk_bf16(__expf(c0), __expf(c1));
        }
    }
    __syncthreads();
}

constexpr int G_DEC = 0, G_QT = 512, G_KT = G_QT + 17408, G_KET = G_KT + 17408, G_VT = G_KET + 18432, G_ATT = G_VT + 18432, G_ST = G_ATT + 9216;
static_assert(G_ST + 34816 <= LDS_BYTES, "gla lds");

struct GlaRegs { unsigned q2[8], k2[8], e2[8], ed; u32x4 vv[2]; };

__device__ __forceinline__ void gla_item(LAS unsigned char* lds, const Params& P, int seq, int head, int dir, int vs) {
    const int tid = otid(), wid = tid >> 6, lane = tid & 63;
    const int r0 = seq < 16 ? seq * 4096 : T0 + (seq - 16) * 8192, L = seq < 16 ? 4096 : 8192, nch = L >> 6;
    const int p = lane, tg = wid;
    const unsigned char* QK = P.ws + WS_S1;
    const unsigned char* V = P.ws + WS_S2;
    const unsigned char* EQ = P.ws + WS_S5;
    unsigned char* O = (unsigned char*)P.out + (dir ? U : 0);
    f32x16 Sacc[2];
#pragma unroll
    for (int t = 0; t < 2; ++t)
#pragma unroll
        for (int i = 0; i < 16; ++i) Sacc[t][i] = 0.f;
    auto load_chunk = [&](GlaRegs& R, int step) {
        const int ci = dir ? nch - 1 - step : step, rc = r0 + ci * 64;
#pragma unroll
        for (int i = 0; i < 8; ++i) {
            const size_t row = (size_t)(rc + 8 * tg + i) * 2048;
            R.q2[i] = *(const unsigned*)(QK + row + (head * 128 + 2 * p) * 2);
            R.k2[i] = *(const unsigned*)(QK + row + 1024 + (head * 128 + 2 * p) * 2);
            R.e2[i] = *(const unsigned*)(EQ + row + (dir * 512 + head * 128 + 2 * p) * 2);
        }
        R.ed = *(const unsigned*)(EQ + (size_t)(rc + (dir ? 0 : 63)) * 2048 + (dir * 512 + head * 128 + 2 * p) * 2);
        const unsigned char* vp = V + (size_t)(rc + (tid >> 3)) * 2048 + (head * 256 + vs * 128 + (tid & 7) * 16) * 2;
        R.vv[0] = *(const u32x4*)vp; R.vv[1] = *(const u32x4*)(vp + 16);
    };
    const int mi = wid >> 1, c31 = lane & 31, hh = lane >> 5, l15 = lane & 15, l4 = lane >> 4;
    LAS unsigned char* ST = lds + G_ST;
    auto do_step = [&](GlaRegs& R, int step) {
        const int ci = dir ? nch - 1 - step : step, rc = r0 + ci * 64;
#pragma unroll
        for (int t = 0; t < 2; ++t) {
            const int ni = (wid & 1) * 2 + t;
#pragma unroll
            for (int g = 0; g < 4; ++g)
                *(LAS u32x2*)(ST + (32 * ni + c31) * 272 + (32 * mi + 8 * g + 4 * hh) * 2) = (u32x2){pk_bf16(Sacc[t][4 * g], Sacc[t][4 * g + 1]), pk_bf16(Sacc[t][4 * g + 2], Sacc[t][4 * g + 3])};
        }
        {
            const float dec0 = bf_lo(R.ed), dec1 = bf_hi(R.ed);
            unsigned ke0[4], ke1[4];
            float pe0 = 0.f, pe1 = 0.f;
#pragma unroll
            for (int i = 0; i < 8; ++i) {
                const float eq0 = bf_lo(R.e2[i]), eq1 = bf_hi(R.e2[i]);
                const float ek0 = __builtin_amdgcn_rcpf(eq0), ek1 = __builtin_amdgcn_rcpf(eq1);
                const float kl = bf_lo(R.k2[i]) * ek0, kh = bf_hi(R.k2[i]) * ek1;
                const int tok = 8 * tg + i;
                *(LAS unsigned*)(lds + G_QT + tok * 272 + 4 * p) = pk_bf16(bf_lo(R.q2[i]) * eq0, bf_hi(R.q2[i]) * eq1);
                *(LAS unsigned*)(lds + G_KT + tok * 272 + 4 * p) = pk_bf16(kl, kh);
                const float e0 = kl * dec0, e1 = kh * dec1;
                if (i & 1) { ke0[i >> 1] = pk_bf16(pe0, e0); ke1[i >> 1] = pk_bf16(pe1, e1); } else { pe0 = e0; pe1 = e1; }
            }
            *(LAS u32x4*)(lds + G_KET + (2 * p) * 144 + 16 * tg) = (u32x4){ke0[0], ke0[1], ke0[2], ke0[3]};
            *(LAS u32x4*)(lds + G_KET + (2 * p + 1) * 144 + 16 * tg) = (u32x4){ke1[0], ke1[1], ke1[2], ke1[3]};
            if (tg == 0) *(LAS f32x2*)(lds + G_DEC + 8 * p) = (f32x2){dec0, dec1};
        }
        {
            const int tok = tid >> 3, seg = tid & 7;
#pragma unroll
            for (int h2 = 0; h2 < 2; ++h2)
#pragma unroll
                for (int j = 0; j < 4; ++j) {
                    *(LAS unsigned short*)(lds + G_VT + (seg * 16 + h2 * 8 + 2 * j) * 144 + ((tok ^ (8 * seg)) * 2)) = (unsigned short)(R.vv[h2][j] & 0xffffu);
                    *(LAS unsigned short*)(lds + G_VT + (seg * 16 + h2 * 8 + 2 * j + 1) * 144 + ((tok ^ (8 * seg)) * 2)) = (unsigned short)(R.vv[h2][j] >> 16);
                }
        }
        if (step + 2 < nch) load_chunk(R, step + 2);
        __syncthreads();
        {
            const int ti = wid >> 1;
#pragma unroll
            for (int tt = 0; tt < 2; ++tt) {
                const int tj = (wid & 1) * 2 + tt;
                f32x4 a4 = {0.f, 0.f, 0.f, 0.f};
                const bool skip = dir == 0 ? (tj > ti) : (tj < ti);
                if (!skip) {
#pragma unroll
                    for (int kk = 0; kk < 4; ++kk) {
                        const bf16x8 X = *(const LAS bf16x8*)(lds + G_KT + (tj * 16 + l15) * 272 + (kk * 32 + l4 * 8) * 2);
                        const bf16x8 Y = *(const LAS bf16x8*)(lds + G_QT + (ti * 16 + l15) * 272 + (kk * 32 + l4 * 8) * 2);
                        a4 = __builtin_amdgcn_mfma_f32_16x16x32_bf16(X, Y, a4, 0, 0, 0);
                    }
                }
                const int i = ti * 16 + l15, j0 = tj * 16 + 4 * l4;
#pragma unroll
                for (int r = 0; r < 4; ++r) { const bool keep = dir == 0 ? (j0 + r <= i) : (j0 + r >= i); a4[r] = keep ? a4[r] : 0.f; }
                *(LAS u32x2*)(lds + G_ATT + i * 144 + j0 * 2) = (u32x2){pk_bf16(a4[0], a4[1]), pk_bf16(a4[2], a4[3])};
            }
        }
        __syncthreads();
        {
            const int ti = wid >> 1;
            bf16x8 Ya[2], Yq[4];
#pragma unroll
            for (int kk = 0; kk < 2; ++kk) Ya[kk] = *(const LAS bf16x8*)(lds + G_ATT + (ti * 16 + l15) * 144 + (kk * 32 + l4 * 8) * 2);
#pragma unroll
            for (int kk = 0; kk < 4; ++kk) Yq[kk] = *(const LAS bf16x8*)(lds + G_QT + (ti * 16 + l15) * 272 + (kk * 32 + l4 * 8) * 2);
#pragma unroll
            for (int tt = 0; tt < 4; ++tt) {
                const int tn = (wid & 1) * 4 + tt;
                f32x4 a4 = {0.f, 0.f, 0.f, 0.f};
#pragma unroll
                for (int kk = 0; kk < 2; ++kk) {
                    const bf16x8 X = *(const LAS bf16x8*)(lds + G_VT + (tn * 16 + l15) * 144 + (((kk * 4 + l4) ^ tn) * 16));
                    a4 = __builtin_amdgcn_mfma_f32_16x16x32_bf16(X, Ya[kk], a4, 0, 0, 0);
                }
#pragma unroll
                for (int kk = 0; kk < 4; ++kk) {
                    const bf16x8 X = *(const LAS bf16x8*)(ST + (tn * 16 + l15) * 272 + (kk * 32 + l4 * 8) * 2);
                    a4 = __builtin_amdgcn_mfma_f32_16x16x32_bf16(X, Yq[kk], a4, 0, 0, 0);
                }
                const int tok = ti * 16 + l15, dv = tn * 16 + 4 * l4;
                *(u32x2*)(O + (size_t)(rc + tok) * 2048 + (head * 256 + vs * 128 + dv) * 2) = (u32x2){pk_bf16(a4[0], a4[1]), pk_bf16(a4[2], a4[3])};
            }
            bf16x8 Ak[4];
#pragma unroll
            for (int kk = 0; kk < 4; ++kk) Ak[kk] = *(const LAS bf16x8*)(lds + G_KET + (32 * mi + c31) * 144 + (16 * kk + 8 * hh) * 2);
#pragma unroll
            for (int g = 0; g < 4; ++g) {
                const f32x4 d4 = *(const LAS f32x4*)(lds + G_DEC + (32 * mi + 8 * g + 4 * hh) * 4);
#pragma unroll
                for (int r = 0; r < 4; ++r) { Sacc[0][4 * g + r] *= d4[r]; Sacc[1][4 * g + r] *= d4[r]; }
            }
#pragma unroll
            for (int t = 0; t < 2; ++t) {
                const int ni = (wid & 1) * 2 + t;
#pragma unroll
                for (int kk = 0; kk < 4; ++kk) {
                    const bf16x8 B = *(const LAS bf16x8*)(lds + G_VT + (32 * ni + c31) * 144 + (((2 * kk + hh) ^ (2 * ni + (c31 >> 4))) * 16));
                    Sacc[t] = __builtin_amdgcn_mfma_f32_32x32x16_bf16(Ak[kk], B, Sacc[t], 0, 0, 0);
                }
            }
        }
        __syncthreads();
    };
    GlaRegs RA, RB;
    load_chunk(RA, 0);
    load_chunk(RB, 1);
    for (int step = 0; step < nch; step += 2) {
        do_step(RA, step);
        do_step(RB, step + 1);
    }
}

__device__ __forceinline__ void phase_gla(LAS unsigned char* lds, const Params& P) {
    const int b = blockIdx.x, G = gridDim.x;
    for (int k = 0; k < 16; ++k) {
        int it = -1;
        if (G == 256) {
            if (b < 32) it = k == 0 ? b : -1;
            else { const int s = (b - 32) + 224 * k; it = s < 256 ? 32 + s : -1; }
        } else { it = b + G * k; if (it >= 288) it = -1; }
        if (it < 0) break;
        int seq, rest;
        if (it < 32) { seq = 16 + (it >> 4); rest = it & 15; } else { seq = (it - 32) >> 4; rest = (it - 32) & 15; }
        gla_item(lds, P, seq, rest >> 2, (rest >> 1) & 1, rest & 1);
    }
}

constexpr int BM = 256, BK = 64, HALF = 128, HTB = HALF * BK * 2, NXCD = 8, WGM = 8;
__device__ __forceinline__ int lds_byte(int r, int c) { const int st = (r >> 4) * 2 + (c >> 5), rr = r & 15, cc = c & 31, ob = rr * 64 + cc * 2; return st * 1024 + (ob ^ (((ob >> 9) & 1) << 5)); }
__device__ __forceinline__ void stage_rc(int b, int& R, int& C) { const int st = b / 1024, sb = b % 1024, swz = sb ^ (((sb >> 9) & 1) << 5); R = (st >> 1) * 16 + swz / 64; C = (st & 1) * 32 + (swz % 64) / 2; }
__device__ __forceinline__ int perm32(int rho) { const int n = rho >> 4, i = rho & 15; return 8 * (i >> 2) + 4 * n + (i & 3); }

enum { T_G1 = 0, T_G1B, T_G2, T_G3, T_G4, T_GU, T_DN };

template <int TY>
__device__ __forceinline__ bool unit_next(int i, int bid, int& pm, int& pn) {
    constexpr int nM = (TY == T_GU || TY == T_DN) ? 160 : 320;
    constexpr int nN = TY == T_G1 ? 21 : TY == T_G1B ? 12 : TY == T_GU ? 22 : 4;
    constexpr int nwg = nM * nN;
    const long L = (long)i * gridDim.x + bid;
    if (L >= nwg) return false;
    int wgid = (int)L;
    { const int q = nwg / NXCD, r = nwg % NXCD, xcd = wgid % NXCD, off = wgid / NXCD; wgid = (xcd < r ? xcd * (q + 1) : r * (q + 1) + (xcd - r) * q) + off; }
    const int nig = WGM * nN, gid = wgid / nig, fm = gid * WGM, gsz = (nM - fm) < WGM ? (nM - fm) : WGM;
    pm = fm + ((wgid % nig) % gsz); pn = (wgid % nig) / gsz;
    return true;
}

template <int TY>
__device__ __forceinline__ void gemm_epilogue(const f32x4 (&acc)[2][2][4][2], const Params& P, int batch, int pm, int pn, int wr, int wc, int fr, int fq) {
    const int row0 = pm * 256 + wr * 64 + fr;
    const int cl0 = wc * 32 + 8 * fq;
    if constexpr (TY == T_G1) {
        if (pn < 12) {
            bf16_t* base = (bf16_t*)(P.ws + WS_S1 + (size_t)(pn >> 2) * U) + (pn & 3) * 256 + cl0;
#pragma unroll
            for (int ai = 0; ai < 2; ++ai)
#pragma unroll
                for (int m = 0; m < 4; ++m)
#pragma unroll
                    for (int bj = 0; bj < 2; ++bj) {
                        const f32x4 v0 = acc[ai][bj][m][0], v1 = acc[ai][bj][m][1];
                        *(u32x4*)(base + (size_t)(row0 + ai * 128 + m * 16) * DM + bj * 128) = (u32x4){pk_bf16(v0[0], v0[1]), pk_bf16(v0[2], v0[3]), pk_bf16(v1[0], v1[1]), pk_bf16(v1[2], v1[3])};
                    }
        } else if (pn == 12) {
            if (wc == 0) {
                float* LR = (float*)(P.ws + WS_LR);
#pragma unroll
                for (int ai = 0; ai < 2; ++ai)
#pragma unroll
                    for (int m = 0; m < 4; ++m) {
                        float* d = LR + (size_t)(row0 + ai * 128 + m * 16) * 32 + 8 * fq;
                        *(f32x4*)d = acc[ai][0][m][0]; *(f32x4*)(d + 4) = acc[ai][0][m][1];
                    }
            }
        } else {
            bf16_t* base = (bf16_t*)(P.ws + WS_S4) + (pn - 13) * 128 + cl0;
#pragma unroll
            for (int ai = 0; ai < 2; ++ai)
#pragma unroll
                for (int m = 0; m < 4; ++m) {
                    const f32x4 v0 = acc[ai][0][m][0] * acc[ai][1][m][0], v1 = acc[ai][0][m][1] * acc[ai][1][m][1];
                    *(u32x4*)(base + (size_t)(row0 + ai * 128 + m * 16) * DM) = (u32x4){pk_bf16(v0[0], v0[1]), pk_bf16(v0[2], v0[3]), pk_bf16(v1[0], v1[1]), pk_bf16(v1[2], v1[3])};
                }
        }
    } else if constexpr (TY == T_G1B) {
        if (pn < 4) {
            const bf16_t* XC = (const bf16_t*)(P.ws + WS_S4);
            bf16_t* OBp = (bf16_t*)(P.ws + WS_S2);
#pragma unroll
            for (int bj = 0; bj < 2; ++bj)
#pragma unroll
                for (int n = 0; n < 2; ++n) {
                    const int col = pn * 256 + bj * 128 + cl0 + 4 * n;
                    const f32x4 w0 = *(const f32x4*)(P.in[I_CW] + col), w1 = *(const f32x4*)(P.in[I_CW] + 1024 + col), w2 = *(const f32x4*)(P.in[I_CW] + 2048 + col), cb = *(const f32x4*)(P.in[I_CB] + col);
#pragma unroll
                    for (int ai = 0; ai < 2; ++ai)
#pragma unroll
                        for (int m = 0; m < 4; ++m) {
                            const int row = row0 + ai * 128 + m * 16;
                            const int lm = row < T0 ? 4095 : 8191, pos = row & lm;
                            const u32x2 z = {0u, 0u};
                            const u32x2 xm = pos == 0 ? z : *(const u32x2*)(XC + (size_t)(row - 1) * DM + col);
                            const u32x2 x0 = *(const u32x2*)(XC + (size_t)row * DM + col);
                            const u32x2 xp = pos == lm ? z : *(const u32x2*)(XC + (size_t)(row + 1) * DM + col);
                            const f32x4 v = acc[ai][bj][m][n];
                            const float c0 = bf_lo(xm[0]) * w0[0] + bf_lo(x0[0]) * w1[0] + bf_lo(xp[0]) * w2[0] + cb[0];
                            const float c1 = bf_hi(xm[0]) * w0[1] + bf_hi(x0[0]) * w1[1] + bf_hi(xp[0]) * w2[1] + cb[1];
                            const float c2 = bf_lo(xm[1]) * w0[2] + bf_lo(x0[1]) * w1[2] + bf_lo(xp[1]) * w2[2] + cb[2];
                            const float c3 = bf_hi(xm[1]) * w0[3] + bf_hi(x0[1]) * w1[3] + bf_hi(xp[1]) * w2[3] + cb[3];
                            *(u32x2*)(OBp + (size_t)row * DM + col) = (u32x2){pk_bf16(v[0] * c0, v[1] * c1), pk_bf16(v[2] * c2, v[3] * c3)};
                        }
                }
        } else {
            bf16_t* base = (bf16_t*)(P.ws + (pn < 8 ? WS_S3 : WS_S5)) + (pn & 3) * 256 + cl0;
#pragma unroll
            for (int ai = 0; ai < 2; ++ai)
#pragma unroll
                for (int m = 0; m < 4; ++m)
#pragma unroll
                    for (int bj = 0; bj < 2; ++bj) {
                        const f32x4 v0 = acc[ai][bj][m][0], v1 = acc[ai][bj][m][1];
                        *(u32x4*)(base + (size_t)(row0 + ai * 128 + m * 16) * DM + bj * 128) =
                            (u32x4){pk_bf16(fast_sigmoid(v0[0]), fast_sigmoid(v0[1])), pk_bf16(fast_sigmoid(v0[2]), fast_sigmoid(v0[3])), pk_bf16(fast_sigmoid(v1[0]), fast_sigmoid(v1[1])), pk_bf16(fast_sigmoid(v1[2]), fast_sigmoid(v1[3]))};
                    }
        }
    } else if constexpr (TY == T_G2 || TY == T_G3) {
        bf16_t* M3 = (bf16_t*)(P.ws + WS_S3) + pn * 256 + cl0;
        bf16_t* M5 = (bf16_t*)(P.ws + WS_S5) + pn * 256 + cl0;
#pragma unroll
        for (int ai = 0; ai < 2; ++ai)
#pragma unroll
            for (int m = 0; m < 4; ++m)
#pragma unroll
                for (int bj = 0; bj < 2; ++bj) {
                    const size_t o = (size_t)(row0 + ai * 128 + m * 16) * DM + bj * 128;
                    const f32x4 v0 = acc[ai][bj][m][0], v1 = acc[ai][bj][m][1];
                    if constexpr (TY == T_G2) {
                        const u32x4 g = *(const u32x4*)(M3 + o);
                        *(u32x4*)(M3 + o) = (u32x4){pk_bf16(v0[0] * bf_lo(g[0]), v0[1] * bf_hi(g[0])), pk_bf16(v0[2] * bf_lo(g[1]), v0[3] * bf_hi(g[1])), pk_bf16(v1[0] * bf_lo(g[2]), v1[1] * bf_hi(g[2])), pk_bf16(v1[2] * bf_lo(g[3]), v1[3] * bf_hi(g[3]))};
                    } else {
                        const u32x4 g = *(const u32x4*)(M5 + o), a = *(const u32x4*)(M3 + o);
                        *(u32x4*)(M5 + o) = (u32x4){pk_bf16(bf_lo(a[0]) + v0[0] * bf_lo(g[0]), bf_hi(a[0]) + v0[1] * bf_hi(g[0])), pk_bf16(bf_lo(a[1]) + v0[2] * bf_lo(g[1]), bf_hi(a[1]) + v0[3] * bf_hi(g[1])),
                                                    pk_bf16(bf_lo(a[2]) + v1[0] * bf_lo(g[2]), bf_hi(a[2]) + v1[1] * bf_hi(g[2])), pk_bf16(bf_lo(a[3]) + v1[2] * bf_lo(g[3]), bf_hi(a[3]) + v1[3] * bf_hi(g[3]))};
                    }
                }
    } else if constexpr (TY == T_G4) {
        const float* MOD = (const float*)(P.ws + WS_MOD);
#pragma unroll
        for (int ai = 0; ai < 2; ++ai)
#pragma unroll
            for (int m = 0; m < 4; ++m) {
                const int row = row0 + ai * 128 + m * 16;
                const float* xr = x_row(P, row);
                const float* g1 = MOD + batch_of_row(row) * 6144 + 2048;
#pragma unroll
                for (int bj = 0; bj < 2; ++bj) {
                    const int col = pn * 256 + bj * 128 + cl0;
#pragma unroll
                    for (int n = 0; n < 2; ++n) {
                        const f32x4 xv = *(const f32x4*)(xr + col + 4 * n), gv = *(const f32x4*)(g1 + col + 4 * n);
                        *(f32x4*)(P.out + (size_t)row * DM + col + 4 * n) = xv + gv * acc[ai][bj][m][n];
                    }
                }
            }
    } else if constexpr (TY == T_GU) {
        bf16_t* Hh = (bf16_t*)(P.ws + WS_H) + pn * 128 + cl0;
#pragma unroll
        for (int ai = 0; ai < 2; ++ai)
#pragma unroll
            for (int m = 0; m < 4; ++m) {
                float h[8];
#pragma unroll
                for (int n = 0; n < 2; ++n)
#pragma unroll
                    for (int j = 0; j < 4; ++j) { const float gt = acc[ai][0][m][n][j]; h[4 * n + j] = gt * fast_sigmoid(gt) * acc[ai][1][m][n][j]; }
                *(u32x4*)(Hh + (size_t)(row0 + ai * 128 + m * 16) * DE) = (u32x4){pk_bf16(h[0], h[1]), pk_bf16(h[2], h[3]), pk_bf16(h[4], h[5]), pk_bf16(h[6], h[7])};
            }
    } else if constexpr (TY == T_DN) {
        const float* GV = (const float*)(P.ws + WS_GVAL) + (size_t)batch * ROWS_B;
        bf16_t* YE = (bf16_t*)(P.ws + WS_YE) + (size_t)batch * ROWS_B * DM + pn * 256 + cl0;
#pragma unroll
        for (int ai = 0; ai < 2; ++ai)
#pragma unroll
            for (int m = 0; m < 4; ++m) {
                const int row = row0 + ai * 128 + m * 16;
                const float g = GV[row];
#pragma unroll
                for (int bj = 0; bj < 2; ++bj) {
                    const f32x4 v0 = acc[ai][bj][m][0] * g, v1 = acc[ai][bj][m][1] * g;
                    *(u32x4*)(YE + (size_t)row * DM + bj * 128) = (u32x4){pk_bf16(v0[0], v0[1]), pk_bf16(v0[2], v0[3]), pk_bf16(v1[0], v1[1]), pk_bf16(v1[2], v1[3])};
                }
            }
    }
}

template <int TY>
__device__ __forceinline__ void gemm_phase(LAS unsigned char* lds, const Params& P, int batch) {
    constexpr int K = TY == T_DN ? DE : DM, nt = K / BK;
    constexpr bool GATHER = TY == T_GU;
    const int tid = otid(), wid = __builtin_amdgcn_readfirstlane(tid >> 6), lane = tid & 63, wr = wid >> 2, wc = wid & 3, fr = lane & 15, fq = lane >> 4;
    const unsigned char* Abase = P.ws + (TY == T_G1 || TY == T_G1B ? WS_S0 : TY == T_G2 ? WS_S1 : TY == T_G3 ? WS_S2 : TY == T_G4 ? WS_S5 : TY == T_GU ? WS_S0 : WS_H);
    const unsigned char* Bbase = P.ws + (TY == T_G1 ? WS_WB1 : TY == T_G1B ? WS_WB1 + (size_t)5376 * 1024 * 2 : TY == T_G2 ? WS_WBA : TY == T_G3 ? WS_WBB : TY == T_G4 ? WS_WBO : TY == T_GU ? WS_WGU : WS_WDN);
    const int* TOK = (const int*)(P.ws + WS_TOKOF) + (size_t)batch * ROWS_B;
    constexpr size_t tstep = (size_t)256 * K * 2, hstepB = (size_t)128 * K * 2, kstep = BK * 2;
    int Rs[2], Cs[2];
    unsigned voffB[2], voffA[2][2], voffAn[2][2];
    constexpr size_t hstepA = GATHER ? 0 : (size_t)128 * K * 2;
#pragma unroll
    for (int i = 0; i < 2; ++i) {
        stage_rc(tid * 16 + i * 8192, Rs[i], Cs[i]);
        const int Rb = (Rs[i] & ~31) + perm32(Rs[i] & 31);
        voffB[i] = (unsigned)(Rb * K + Cs[i]) * 2u;
#pragma unroll
        for (int h = 0; h < 2; ++h) voffA[h][i] = voffAn[h][i] = (unsigned)(Rs[i] * K + Cs[i]) * 2u;
    }
    auto a_ptr = [&](int pm) -> const unsigned char* { return GATHER ? Abase : Abase + (size_t)pm * tstep; };
    auto b_ptr = [&](int pm, int pn) -> const unsigned char* {
        if constexpr (TY == T_GU) return Bbase + (size_t)((batch * 160 + pm) / 40) * 5632 * 1024 * 2 + (size_t)pn * tstep;
        else if constexpr (TY == T_DN) return Bbase + (size_t)((batch * 160 + pm) / 40) * 1024 * DE * 2 + (size_t)pn * tstep;
        else return Bbase + (size_t)pn * tstep;
    };
    auto gather_off = [&](int pm, unsigned (&vo)[2][2]) {
#pragma unroll
        for (int h = 0; h < 2; ++h)
#pragma unroll
            for (int i = 0; i < 2; ++i) vo[h][i] = (unsigned)TOK[pm * 256 + h * 128 + Rs[i]] * 2048u + (unsigned)Cs[i] * 2u;
    };
    const unsigned ldsw = (unsigned)wid * 1024u;
    const int aoff = lds_byte(wr * 64 + fr, fq * 8), boff = lds_byte(wc * 32 + fr, fq * 8);
#define G_SA(b, h) (((b) * 2 + (h)) * HTB)
#define G_SB(b, h) ((4 + (b) * 2 + (h)) * HTB)
#define G_STAGE(bufoff, gbase, v0, v1) do { \
        __builtin_amdgcn_global_load_lds((const unsigned*)((gbase) + (v0)), (LAS unsigned*)(lds + (bufoff) + ldsw), 16, 0, 0); \
        __builtin_amdgcn_global_load_lds((const unsigned*)((gbase) + (v1)), (LAS unsigned*)(lds + (bufoff) + ldsw + 8192), 16, 0, 0); } while (0)
#define G_LDA(dst, b, h) do { _Pragma("unroll") for (int m = 0; m < 4; ++m) _Pragma("unroll") for (int k = 0; k < 2; ++k) dst[m][k] = *(const LAS bf16x8*)(lds + G_SA(b, h) + aoff + m * 2048 + k * 1024); } while (0)
#define G_LDB(dst, b, h) do { _Pragma("unroll") for (int n = 0; n < 2; ++n) _Pragma("unroll") for (int k = 0; k < 2; ++k) dst[n][k] = *(const LAS bf16x8*)(lds + G_SB(b, h) + boff + n * 2048 + k * 1024); } while (0)
#define G_MMA(ai, bj, At, Bt) do { __builtin_amdgcn_s_setprio(1); _Pragma("unroll") for (int m = 0; m < 4; ++m) _Pragma("unroll") for (int n = 0; n < 2; ++n) _Pragma("unroll") for (int k = 0; k < 2; ++k) \
        acc[ai][bj][m][n] = __builtin_amdgcn_mfma_f32_16x16x32_bf16(Bt[n][k], At[m][k], acc[ai][bj][m][n], 0, 0, 0); __builtin_amdgcn_s_setprio(0); } while (0)
#define G_WAIT_V(n) asm volatile("s_waitcnt vmcnt(" #n ")" ::: "memory")
#define G_WAIT_L(n) asm volatile("s_waitcnt lgkmcnt(" #n ")" ::: "memory")
#define G_BAR __builtin_amdgcn_s_barrier()
#define G_SCHED __builtin_amdgcn_sched_barrier(0)
    int cpm, cpn, npm = 0, npn = 0, ui = 0;
    int bid = blockIdx.x; asm volatile("" : "+v"(bid)); bid = __builtin_amdgcn_readfirstlane(bid);
    if (!unit_next<TY>(0, bid, cpm, cpn)) return;
    f32x4 acc[2][2][4][2];
#pragma unroll
    for (int a = 0; a < 2; ++a)
#pragma unroll
        for (int b = 0; b < 2; ++b)
#pragma unroll
            for (int m = 0; m < 4; ++m)
#pragma unroll
                for (int n = 0; n < 2; ++n) acc[a][b][m][n] = (f32x4){0.f, 0.f, 0.f, 0.f};
    bf16x8 At[4][2], B0[2][2], B1[2][2];
    const unsigned char* cA = a_ptr(cpm);
    const unsigned char* cB = b_ptr(cpm, cpn);
    if constexpr (GATHER) gather_off(cpm, voffA);
    G_STAGE(G_SB(0, 0), cB, voffB[0], voffB[1]); G_STAGE(G_SA(0, 0), cA, voffA[0][0], voffA[0][1]);
    G_STAGE(G_SB(0, 1), cB + hstepB, voffB[0], voffB[1]); G_STAGE(G_SA(0, 1), cA + hstepA, voffA[1][0], voffA[1][1]);
    if (wr == 1) G_BAR;
    G_WAIT_V(4); G_BAR;
    G_STAGE(G_SB(1, 0), cB + kstep, voffB[0], voffB[1]); G_STAGE(G_SA(1, 0), cA + kstep, voffA[0][0], voffA[0][1]); G_STAGE(G_SB(1, 1), cB + hstepB + kstep, voffB[0], voffB[1]);
    G_WAIT_V(6); G_BAR;
    for (;;) {
        const bool has_next = unit_next<TY>(ui + 1, bid, npm, npn);
        const unsigned char* nA = has_next ? a_ptr(npm) : cA;
        const unsigned char* nB = has_next ? b_ptr(npm, npn) : cB;
        if constexpr (GATHER) {
            if (has_next) gather_off(npm, voffAn);
            else {
#pragma unroll
                for (int h = 0; h < 2; ++h)
#pragma unroll
                    for (int i = 0; i < 2; ++i) voffAn[h][i] = voffA[h][i];
            }
        }
        for (int t = 0; t < nt; t += 2) {
            const bool last = (t == nt - 2);
            const unsigned char* a1 = cA + (size_t)(t + 1) * kstep;
            const unsigned char* a2 = last ? nA : cA + (size_t)(t + 2) * kstep;
            const unsigned char* b2 = last ? nB : cB + (size_t)(t + 2) * kstep;
            const unsigned char* a3 = a2 + kstep;
            const unsigned char* b3 = b2 + kstep;
            unsigned va00 = voffA[0][0], va01 = voffA[0][1], va10 = voffA[1][0], va11 = voffA[1][1];
            if constexpr (GATHER) { if (last) { va00 = voffAn[0][0]; va01 = voffAn[0][1]; va10 = voffAn[1][0]; va11 = voffAn[1][1]; } }
            G_LDB(B0, 0, 0); G_SCHED; G_LDA(At, 0, 0); G_STAGE(G_SA(1, 1), a1 + hstepA, voffA[1][0], voffA[1][1]);
            G_WAIT_L(8); G_BAR; G_WAIT_L(0); G_MMA(0, 0, At, B0); G_BAR; G_SCHED;
            G_LDB(B1, 0, 1); G_STAGE(G_SB(0, 0), b2, voffB[0], voffB[1]);
            G_BAR; G_WAIT_L(0); G_MMA(0, 1, At, B1); G_BAR;
            G_LDA(At, 0, 1); G_STAGE(G_SA(0, 0), a2, va00, va01);
            G_BAR; G_WAIT_L(0); G_MMA(1, 0, At, B0); G_BAR; G_SCHED;
            G_STAGE(G_SB(0, 1), b2 + hstepB, voffB[0], voffB[1]);
            G_WAIT_V(6); G_BAR; G_MMA(1, 1, At, B1); G_BAR;
            G_LDB(B0, 1, 0); G_SCHED; G_LDA(At, 1, 0); G_STAGE(G_SA(0, 1), a2 + hstepA, va10, va11);
            G_WAIT_L(8); G_BAR; G_WAIT_L(0); G_MMA(0, 0, At, B0); G_BAR; G_SCHED;
            G_LDB(B1, 1, 1); G_STAGE(G_SB(1, 0), b3, voffB[0], voffB[1]);
            G_BAR; G_WAIT_L(0); G_MMA(0, 1, At, B1); G_BAR;
            G_LDA(At, 1, 1); G_STAGE(G_SA(1, 0), a3, va00, va01);
            G_BAR; G_WAIT_L(0); G_MMA(1, 0, At, B0); G_BAR; G_SCHED;
            G_STAGE(G_SB(1, 1), b3 + hstepB, voffB[0], voffB[1]);
            G_WAIT_V(6); G_BAR; G_MMA(1, 1, At, B1); G_BAR;
        }
        gemm_epilogue<TY>(acc, P, batch, cpm, cpn, wr, wc, fr, fq);
        if (!has_next) break;
#pragma unroll
        for (int a = 0; a < 2; ++a)
#pragma unroll
            for (int b = 0; b < 2; ++b)
#pragma unroll
                for (int m = 0; m < 4; ++m)
#pragma unroll
                    for (int n = 0; n < 2; ++n) acc[a][b][m][n] = (f32x4){0.f, 0.f, 0.f, 0.f};
        cpm = npm; cpn = npn; cA = nA; cB = nB; ++ui;
        if constexpr (GATHER) {
#pragma unroll
            for (int h = 0; h < 2; ++h)
#pragma unroll
                for (int i = 0; i < 2; ++i) voffA[h][i] = voffAn[h][i];
        }
    }
    G_WAIT_V(0);
    if (wr == 0) G_BAR;
    G_BAR;
#undef G_SA
#undef G_SB
#undef G_STAGE
#undef G_LDA
#undef G_LDB
#undef G_MMA
#undef G_WAIT_V
#undef G_WAIT_L
#undef G_BAR
#undef G_SCHED
}

#ifndef DBG_MASK
#define DBG_MASK 0
#endif
__device__ __forceinline__ void phase_dbg(const Params& P) {
    const int tid = otid();
    for (size_t i = (size_t)blockIdx.x * NTHREADS + tid; i < (size_t)NT * DM; i += (size_t)gridDim.x * NTHREADS) {
        float a = 0.f;
        for (int k = 0; k < 6; ++k) if ((DBG_MASK >> k) & 1) a += bf_lo(((const bf16_t*)(P.ws + (size_t)k * U))[i]);
        if ((DBG_MASK >> 6) & 1) a += ((const float*)(P.ws + WS_LR))[(i >> 10) * 32 + (i & 31)];
        P.out[i] = a;
    }
}

constexpr int N_PHASES = 21;
__global__ void __launch_bounds__(NTHREADS) mega_fwd(Params P) {
    extern __shared__ __attribute__((aligned(16))) unsigned char lds_raw[];
    LAS unsigned char* lds = (LAS unsigned char*)lds_raw;
#ifndef PM
#endif
#ifndef DUP
#define DUP 0x4
#endif
#define PHASE(n, ...) if (((PM >> (n)) & 1) && P.ph_lo <= (n) && (n) < P.ph_hi) { __VA_ARGS__; if ((DUP >> (n)) & 1) { if (P.coop) cg::this_grid().sync(); __VA_ARGS__; } if ((n) + 1 < P.ph_hi && P.coop) cg::this_grid().sync(); }
    PHASE(0, if (blockIdx.x == 0 && threadIdx.x == 0) *(unsigned*)(P.ws + WS_CNT) = 0u; phase_mod(lds, P); phase_convert_mixer(lds, P))
    PHASE(1, phase_norm1(P))
    PHASE(2, gemm_phase<T_G1>(lds, P, 0))
    PHASE(3, phase_glaprep(lds, P); if (P.coop) cg::this_grid().sync(); phase_gla(lds, P))
    PHASE(4, phase_oaprep(P))
    PHASE(5, gemm_phase<T_G1B>(lds, P, 0))
    PHASE(6, gemm_phase<T_G2>(lds, P, 0); gemm_phase<T_G3>(lds, P, 0))
    PHASE(8, gemm_phase<T_G4>(lds, P, 0))
    PHASE(9, phase_norm2(lds, P))
    PHASE(10, if (blockIdx.x < 32) phase_topk_item(lds, P, blockIdx.x); convert_moe(lds, P))
    for (int b = 0; b < 4; ++b) {
        if (((PM >> 11) & 1) && P.ph_lo <= 11 + 2 * b && 11 + 2 * b < P.ph_hi) { gemm_phase<T_GU>(lds, P, b); if (P.coop) cg::this_grid().sync(); }
        if (((PM >> 12) & 1) && P.ph_lo <= 12 + 2 * b && 12 + 2 * b < P.ph_hi) { gemm_phase<T_DN>(lds, P, b); if (P.coop) cg::this_grid().sync(); }
    }
    PHASE(19, phase_final(P))
    if (DBG_MASK && P.ph_lo <= 20 && 20 < P.ph_hi) phase_dbg(P);
}

extern "C" void kernel_launch(void* const* d_in, const int* in_sizes, int n_in, void* d_out, int out_size, void* d_ws, size_t ws_size, hipStream_t stream) {
    static int grid = 0;
    if (grid == 0) {
        int dev = 0, cus = 0, per_cu = 0;
        hipGetDevice(&dev);
        hipDeviceGetAttribute(&cus, hipDeviceAttributeMultiprocessorCount, dev);
        hipFuncSetAttribute((const void*)mega_fwd, hipFuncAttributeMaxDynamicSharedMemorySize, LDS_BYTES);
        hipOccupancyMaxActiveBlocksPerMultiprocessor(&per_cu, (const void*)mega_fwd, NTHREADS, LDS_BYTES);
        (void)hipGetLastError();
        grid = cus > 0 ? cus : 256;
        if (ws_size < ((size_t)1 << 30)) fprintf(stderr, "kernel_launch: workspace %zu smaller than the 1 GiB map\n", ws_size);
    }
    Params p{};
    for (int i = 0; i < 24; ++i) p.in[i] = (const float*)d_in[i];
    p.out = (float*)d_out; p.ws = (unsigned char*)d_ws;
#if MEGA
    p.ph_lo = 0; p.ph_hi = N_PHASES; p.coop = 1; p.pad = 0;
    void* args[] = {&p};
    hipError_t e = hipLaunchCooperativeKernel((const void*)mega_fwd, dim3(grid), dim3(NTHREADS), args, LDS_BYTES, stream);
    if (e != hipSuccess) fprintf(stderr, "cooperative launch failed: %s (grid %d)\n", hipGetErrorString(e), grid);
#else
    for (int ph = 0; ph < N_PHASES; ++ph) {
        p.ph_lo = ph; p.ph_hi = ph + 1; p.coop = 0; p.pad = 0;
        hipLaunchKernelGGL(mega_fwd, dim3(grid), dim3(NTHREADS), LDS_BYTES, stream, p);
    }
#endif
}
```

```cpp
#include <hip/hip_runtime.h>
#include <hip/hip_cooperative_groups.h>
#include <cstdio>
namespace cg = cooperative_groups;

#ifndef PM
#define PM 0xFFFFF
#endif
#ifndef DBG_MASK
#define DBG_MASK 0
#endif
#define DUP 0
#ifndef REPA
#define REPA 1
#endif
#ifndef MEGA
#define MEGA 1
#endif

#define LAS __attribute__((address_space(3)))
typedef unsigned short bf16_t;
typedef short bf16x8 __attribute__((ext_vector_type(8)));
typedef float f32x2 __attribute__((ext_vector_type(2)));
typedef float f32x4 __attribute__((ext_vector_type(4)));
typedef float f32x16 __attribute__((ext_vector_type(16)));
typedef unsigned u32x2 __attribute__((ext_vector_type(2)));
typedef unsigned u32x4 __attribute__((ext_vector_type(4)));

constexpr int NT = 81920;
constexpr int T0 = 65536;
constexpr int DM = 1024;
constexpr int DIN = 8224;
constexpr int NE = 16;
constexpr int DE = 2816;
constexpr int ROWS_E = 10240;
constexpr int ROWS_B = 40960;
constexpr float EPS = 1e-6f;
constexpr int LDS_BYTES = 131072 + 16;
constexpr int NTHREADS = 512;

constexpr size_t U = (size_t)NT * DM * 2;
constexpr size_t WS_S0 = 0, WS_S1 = U, WS_S2 = 2 * U, WS_S3 = 3 * U, WS_S4 = 4 * U, WS_S5 = 5 * U;
constexpr size_t WS_WB1 = 6 * U;
constexpr size_t WS_WBA = WS_WB1 + (size_t)8448 * 1024 * 2;
constexpr size_t WS_WBB = WS_WBA + (size_t)1024 * 1024 * 2;
constexpr size_t WS_WBO = WS_WBB + (size_t)1024 * 1024 * 2;
constexpr size_t WS_LR = WS_WBO + (size_t)1024 * 1024 * 2;
constexpr size_t WS_TAIL = ((size_t)1 << 30) - ((size_t)16 << 20);
constexpr size_t WS_MOD = WS_TAIL;
constexpr size_t WS_AFFT = WS_TAIL + ((size_t)512 << 10);
constexpr size_t WS_TOKOF = WS_AFFT + ((size_t)5 << 20);
constexpr size_t WS_GVAL = WS_TOKOF + ((size_t)640 << 10);
constexpr size_t WS_SLOTOF = WS_GVAL + ((size_t)640 << 10);
constexpr size_t WS_WGU = U;
constexpr size_t WS_WDN = WS_WGU + (size_t)16 * 5632 * 1024 * 2;
constexpr size_t WS_H = WS_WDN + (size_t)16 * 1024 * 2816 * 2;
constexpr size_t WS_YE = WS_H + (size_t)ROWS_B * DE * 2;
static_assert(WS_LR + (size_t)NT * 32 * 4 <= WS_TAIL, "ws map");
static_assert(WS_YE + 2 * U <= WS_TAIL, "ws map");
static_assert(WS_SLOTOF + (size_t)NT * 16 * 4 <= ((size_t)1 << 30), "ws map");

struct Params {
    const float* in[24];
    float* out;
    unsigned char* ws;
    int ph_lo, ph_hi, coop, pad;
};
enum { I_XP = 0, I_XS, I_CP, I_CS, I_WADA, I_BADA, I_N1W, I_WIN, I_WAF, I_BAF, I_WAB, I_BAB, I_GNW, I_CW, I_CB, I_WOA, I_WOB, I_WO, I_N2W, I_WR, I_WG, I_WU, I_WD, I_NFW };

typedef __bf16 bf16x2_t __attribute__((ext_vector_type(2)));
__device__ __forceinline__ unsigned pk_bf16(float lo, float hi) { bf16x2_t v = {(__bf16)lo, (__bf16)hi}; return __builtin_bit_cast(unsigned, v); }
__device__ __forceinline__ float bf_lo(unsigned w) { return __uint_as_float(w << 16); }
__device__ __forceinline__ float bf_hi(unsigned w) { return __uint_as_float(w & 0xffff0000u); }
__device__ __forceinline__ float fast_sigmoid(float x) { return __builtin_amdgcn_rcpf(1.0f + __expf(-x)); }
__device__ __forceinline__ float wave_sum(float v) {
#pragma unroll
    for (int m = 32; m >= 1; m >>= 1) v += __shfl_xor(v, m);
    return v;
}
__device__ __forceinline__ int otid() { int t = threadIdx.x; asm volatile("" : "+v"(t)); return t; }
__device__ __forceinline__ int batch_of_row(int row) { return row < T0 ? (row >> 12) : 16 + ((row - T0) >> 13); }
__device__ __forceinline__ const float* x_row(const Params& P, int row) { return row < T0 ? P.in[I_XP] + (size_t)row * DM : P.in[I_XS] + (size_t)(row - T0) * DM; }

__device__ __forceinline__ void phase_mod(LAS unsigned char* lds, const Params& P) {
    LAS float* sc = (LAS float*)lds;
    float* MOD = (float*)(P.ws + WS_MOD);
    const int tid = otid();
    for (int chunk = blockIdx.x; chunk < 18 * 12; chunk += gridDim.x) {
        const int b = chunk / 12, j = (chunk % 12) * 512 + tid;
        const float* c = b < 16 ? P.in[I_CP] + b * DM : P.in[I_CS] + (b - 16) * DM;
        __syncthreads();
        for (int k = tid; k < DM; k += NTHREADS) { float v = c[k]; sc[k] = v / (1.0f + __expf(-v)); }
        __syncthreads();
        const float* w = P.in[I_WADA] + j;
        float a0 = 0.f, a1 = 0.f, a2 = 0.f, a3 = 0.f;
        for (int k = 0; k < DM; k += 4) {
            a0 += sc[k] * w[(size_t)k * 6144];
            a1 += sc[k + 1] * w[(size_t)(k + 1) * 6144];
            a2 += sc[k + 2] * w[(size_t)(k + 2) * 6144];
            a3 += sc[k + 3] * w[(size_t)(k + 3) * 6144];
        }
        MOD[b * 6144 + j] = (a0 + a1) + (a2 + a3) + P.in[I_BADA][j];
    }
    __syncthreads();
}

__device__ __forceinline__ void convert_tile(LAS unsigned char* lds, const float* src, int ld_src, int colA, int colB, float scale, int k0, bf16_t* dst, int ld_dst) {
    LAS float* tile = (LAS float*)lds;
    const int tid = otid();
    {
        const int n = tid & 63, kk = tid >> 6;
        const int col = n < 32 ? (colA < 0 ? -1 : colA + n) : (colB < 0 ? -1 : colB + n - 32);
        const float* s = src + (size_t)(k0 + kk) * ld_src + (col < 0 ? 0 : col);
#pragma unroll
        for (int pass = 0; pass < 16; ++pass) {
            float v = col < 0 ? 0.f : s[(size_t)pass * 8 * ld_src] * scale;
            tile[(pass * 8 + kk) * 65 + n] = v;
        }
    }
    __syncthreads();
    {
        const int n = tid >> 3, ks = tid & 7;
        unsigned w[8];
#pragma unroll
        for (int j = 0; j < 8; ++j) w[j] = pk_bf16(tile[(ks * 16 + 2 * j) * 65 + n], tile[(ks * 16 + 2 * j + 1) * 65 + n]);
        bf16_t* d = dst + (size_t)n * ld_dst + k0 + ks * 16;
        *(u32x4*)d = (u32x4){w[0], w[1], w[2], w[3]};
        *(u32x4*)(d + 8) = (u32x4){w[4], w[5], w[6], w[7]};
    }
    __syncthreads();
}

__device__ __forceinline__ int win_col(int n) {
    if (n < 3072) return n;
    if (n < 3328) { int j = n - 3072; return j < 32 ? 3072 + j : -1; }
    if (n < 5376) { int j = n - 3328, b = j >> 8, w = j & 255; return (w < 128 ? 4128 : 5152) + b * 128 + (w & 127); }
    if (n < 6400) return 3104 + (n - 5376);
    return 6176 + (n - 6400);
}

__device__ __forceinline__ void phase_convert_mixer(LAS unsigned char* lds, const Params& P) {
    for (int t = blockIdx.x; t < 1056 + 384; t += gridDim.x) {
        if (t < 1056) {
            const int rt = t >> 3, kt = t & 7, n0 = rt * 64;
            convert_tile(lds, P.in[I_WIN], DIN, win_col(n0), win_col(n0 + 32), n0 < 512 ? 0.08838834764831845f : 1.0f, kt * 128,
                         (bf16_t*)(P.ws + WS_WB1) + (size_t)n0 * 1024, 1024);
        } else {
            const int u = t - 1056, which = u >> 7, rt = (u & 127) >> 3, kt = u & 7, n0 = rt * 64;
            const float* src = P.in[which == 0 ? I_WOA : which == 1 ? I_WOB : I_WO];
            bf16_t* dst = (bf16_t*)(P.ws + (which == 0 ? WS_WBA : which == 1 ? WS_WBB : WS_WBO));
            convert_tile(lds, src, 1024, n0, n0 + 32, 1.0f, kt * 128, dst + (size_t)n0 * 1024, 1024);
        }
    }
}

constexpr size_t WS_BAR = WS_TAIL + ((size_t)12 << 20);
constexpr size_t WS_CNT = WS_MOD + ((size_t)480 << 10);
struct ConvDesc { const float* src; bf16_t* dst; int ld_src, ld_dst, col, k0; };
__device__ __forceinline__ ConvDesc moe_tile_desc(const Params& P, int t) {
    ConvDesc d;
    const int e = t / 1056, r = t % 1056;
    if (r < 704) {
        const int rt = r >> 3, kt = r & 7, n0 = rt * 64, blk = n0 >> 8, w = n0 & 255;
        d.src = (w < 128 ? P.in[I_WG] : P.in[I_WU]) + (size_t)e * 1024 * DE; d.ld_src = DE; d.col = blk * 128 + (w & 127); d.k0 = kt * 128;
        d.dst = (bf16_t*)(P.ws + WS_WGU) + ((size_t)e * 5632 + n0) * 1024; d.ld_dst = 1024;
    } else {
        const int r2 = r - 704, rt = r2 / 22, kt = r2 % 22, n0 = rt * 64;
        d.src = P.in[I_WD] + (size_t)e * DE * 1024; d.ld_src = 1024; d.col = n0; d.k0 = kt * 128;
        d.dst = (bf16_t*)(P.ws + WS_WDN) + ((size_t)e * 1024 + n0) * DE; d.ld_dst = DE;
    }
    return d;
}
struct ConvRegs { float v[16]; };
__device__ __forceinline__ void conv_load(ConvRegs& R, const ConvDesc& d, int tid) {
    const int n = tid & 63, kk = tid >> 6;
    const float* s = d.src + (size_t)(d.k0 + kk) * d.ld_src + d.col + n;
#pragma unroll
    for (int pass = 0; pass < 16; ++pass) R.v[pass] = s[(size_t)pass * 8 * d.ld_src];
}
__device__ __forceinline__ void conv_store(LAS unsigned char* lds, const ConvRegs& R, const ConvDesc& d, int tid) {
    LAS float* tile = (LAS float*)lds;
    {
        const int n = tid & 63, kk = tid >> 6;
#pragma unroll
        for (int pass = 0; pass < 16; ++pass) tile[(pass * 8 + kk) * 65 + n] = R.v[pass];
    }
    __syncthreads();
    {
        const int n = tid >> 3, ks = tid & 7;
        unsigned w[8];
#pragma unroll
        for (int j = 0; j < 8; ++j) w[j] = pk_bf16(tile[(ks * 16 + 2 * j) * 65 + n], tile[(ks * 16 + 2 * j + 1) * 65 + n]);
        bf16_t* o = d.dst + (size_t)n * d.ld_dst + d.k0 + ks * 16;
        *(u32x4*)o = (u32x4){w[0], w[1], w[2], w[3]};
        *(u32x4*)(o + 8) = (u32x4){w[4], w[5], w[6], w[7]};
    }
    __syncthreads();
}
__device__ __forceinline__ void convert_moe(LAS unsigned char* lds, const Params& P) {
    constexpr int TOTAL = 16 * 1056, BATCH = 8;
    static_assert(TOTAL % BATCH == 0, "batch");
    const int tid = otid();
    unsigned* cnt = (unsigned*)(P.ws + WS_CNT);
    LAS int* bc = (LAS int*)(lds + 40960);
    __syncthreads();
    if (tid == 0) { bc[0] = (int)atomicAdd(cnt, (unsigned)BATCH); bc[1] = (int)atomicAdd(cnt, (unsigned)BATCH); }
    __syncthreads();
    int tb_cur = bc[0], tb_nxt = bc[1], pos = 0;
    __syncthreads();
    if (tb_cur >= TOTAL) return;
    ConvRegs R, Rn;
    ConvDesc d = moe_tile_desc(P, tb_cur), dn = d;
    conv_load(R, d, tid);
    for (;;) {
        const bool newbatch = (pos + 1 == BATCH);
        const int tn = newbatch ? tb_nxt : tb_cur + pos + 1;
        const bool has = tn < TOTAL;
        if (newbatch && tid == 0) bc[0] = (int)atomicAdd(cnt, (unsigned)BATCH);
        if (has) { dn = moe_tile_desc(P, tn); conv_load(Rn, dn, tid); }
        conv_store(lds, R, d, tid);
        if (!has) break;
        if (newbatch) { tb_cur = tb_nxt; tb_nxt = bc[0]; pos = 0; } else ++pos;
        R = Rn; d = dn;
    }
    __syncthreads();
}

__device__ __forceinline__ void phase_norm1(const Params& P) {
    const int tid_ = otid();
    const int lane = tid_ & 63, gw = blockIdx.x * 8 + (tid_ >> 6), nw = gridDim.x * 8;
    const int per = (NT + nw - 1) / nw;
    const int r_lo = gw * per, r_hi = min(NT, r_lo + per);
    const float* MOD = (const float*)(P.ws + WS_MOD);
    bf16_t* Uo = (bf16_t*)(P.ws + WS_S0);
    int curb = -1;
    float A[16], B[16];
    for (int row = r_lo; row < r_hi; ++row) {
        const int b = batch_of_row(row);
        if (b != curb) {
            curb = b;
#pragma unroll
            for (int i = 0; i < 2; ++i)
#pragma unroll
                for (int j = 0; j < 8; ++j) {
                    const int c = 8 * lane + 512 * i + j;
                    A[i * 8 + j] = P.in[I_N1W][c] * (1.0f + MOD[b * 6144 + 1024 + c]);
                    B[i * 8 + j] = MOD[b * 6144 + c];
                }
        }
        const float* xr = x_row(P, row);
        float v[16];
#pragma unroll
        for (int i = 0; i < 2; ++i) {
            const f32x4 a = *(const f32x4*)(xr + 8 * lane + 512 * i), c = *(const f32x4*)(xr + 8 * lane + 512 * i + 4);
            v[i * 8 + 0] = a[0]; v[i * 8 + 1] = a[1]; v[i * 8 + 2] = a[2]; v[i * 8 + 3] = a[3];
            v[i * 8 + 4] = c[0]; v[i * 8 + 5] = c[1]; v[i * 8 + 6] = c[2]; v[i * 8 + 7] = c[3];
        }
        float ss = 0.f;
#pragma unroll
        for (int j = 0; j < 16; ++j) ss += v[j] * v[j];
        ss = wave_sum(ss);
        const float rstd = rsqrtf(ss * (1.0f / 1024.0f) + EPS);
#pragma unroll
        for (int i = 0; i < 2; ++i) {
            unsigned w[4];
#pragma unroll
            for (int j = 0; j < 4; ++j) w[j] = pk_bf16(v[i * 8 + 2 * j] * rstd * A[i * 8 + 2 * j] + B[i * 8 + 2 * j], v[i * 8 + 2 * j + 1] * rstd * A[i * 8 + 2 * j + 1] + B[i * 8 + 2 * j + 1]);
            *(u32x4*)(Uo + (size_t)row * DM + 8 * lane + 512 * i) = (u32x4){w[0], w[1], w[2], w[3]};
        }
    }
}

__device__ __forceinline__ void phase_oaprep(const Params& P) {
    const int tid_ = otid();
    const int lane = tid_ & 63, gw = blockIdx.x * 8 + (tid_ >> 6), nw = gridDim.x * 8;
    const bf16_t* OF = (const bf16_t*)P.out;
    const bf16_t* OB = OF + (size_t)NT * DM;
    const bf16_t* R = (const bf16_t*)(P.ws + WS_S3);
    bf16_t* OA = (bf16_t*)(P.ws + WS_S1);
    float g[16];
#pragma unroll
    for (int j = 0; j < 16; ++j) g[j] = P.in[I_GNW][16 * lane + j];
    for (int row = gw; row < NT; row += nw) {
        const size_t off = (size_t)row * DM + 16 * lane;
        const u32x4 f0 = *(const u32x4*)(OF + off), f1 = *(const u32x4*)(OF + off + 8);
        const u32x4 b0 = *(const u32x4*)(OB + off), b1 = *(const u32x4*)(OB + off + 8);
        const u32x4 r0 = *(const u32x4*)(R + off), r1 = *(const u32x4*)(R + off + 8);
        float o[16], rr[16];
#pragma unroll
        for (int j = 0; j < 4; ++j) {
            o[2 * j] = bf_lo(f0[j]) + bf_lo(b0[j]); o[2 * j + 1] = bf_hi(f0[j]) + bf_hi(b0[j]);
            o[8 + 2 * j] = bf_lo(f1[j]) + bf_lo(b1[j]); o[8 + 2 * j + 1] = bf_hi(f1[j]) + bf_hi(b1[j]);
            rr[2 * j] = bf_lo(r0[j]); rr[2 * j + 1] = bf_hi(r0[j]); rr[8 + 2 * j] = bf_lo(r1[j]); rr[8 + 2 * j + 1] = bf_hi(r1[j]);
        }
        float ss = 0.f;
#pragma unroll
        for (int j = 0; j < 16; ++j) ss += o[j] * o[j];
        ss += __shfl_xor(ss, 1); ss += __shfl_xor(ss, 2); ss += __shfl_xor(ss, 4); ss += __shfl_xor(ss, 8);
        const float rstd = rsqrtf(ss * (1.0f / 256.0f) + EPS);
        unsigned w[8];
#pragma unroll
        for (int j = 0; j < 8; ++j) {
            const float a = o[2 * j] * rstd * g[2 * j] * (rr[2 * j] * fast_sigmoid(rr[2 * j]));
            const float c = o[2 * j + 1] * rstd * g[2 * j + 1] * (rr[2 * j + 1] * fast_sigmoid(rr[2 * j + 1]));
            w[j] = pk_bf16(a, c);
        }
        *(u32x4*)(OA + off) = (u32x4){w[0], w[1], w[2], w[3]};
        *(u32x4*)(OA + off + 8) = (u32x4){w[4], w[5], w[6], w[7]};
    }
}

__device__ __forceinline__ void phase_norm2(LAS unsigned char* lds, const Params& P) {
    LAS float* wrT = (LAS float*)lds;
    const int tid = otid();
    for (int i = tid; i < DM * NE; i += NTHREADS) wrT[(i & 15) * 1024 + (i >> 4)] = P.in[I_WR][i];
    __syncthreads();
    const int lane = tid & 63, gw = blockIdx.x * 8 + (tid >> 6), nw = gridDim.x * 8;
    const int per = (NT + nw - 1) / nw;
    const int r_lo = gw * per, r_hi = min(NT, r_lo + per);
    const float* MOD = (const float*)(P.ws + WS_MOD);
    const float* X1 = P.out;
    bf16_t* Uo = (bf16_t*)(P.ws + WS_S0);
    float* AFFT = (float*)(P.ws + WS_AFFT);
    int curb = -1;
    float A[16], B[16];
    for (int row = r_lo; row < r_hi; ++row) {
        const int b = batch_of_row(row);
        if (b != curb) {
            curb = b;
#pragma unroll
            for (int i = 0; i < 2; ++i)
#pragma unroll
                for (int j = 0; j < 8; ++j) {
                    const int c = 8 * lane + 512 * i + j;
                    A[i * 8 + j] = P.in[I_N2W][c] * (1.0f + MOD[b * 6144 + 4096 + c]);
                    B[i * 8 + j] = MOD[b * 6144 + 3072 + c];
                }
        }
        const float* xr = X1 + (size_t)row * DM;
        float v[16];
#pragma unroll
        for (int i = 0; i < 2; ++i) {
            const f32x4 a = *(const f32x4*)(xr + 8 * lane + 512 * i), c = *(const f32x4*)(xr + 8 * lane + 512 * i + 4);
            v[i * 8 + 0] = a[0]; v[i * 8 + 1] = a[1]; v[i * 8 + 2] = a[2]; v[i * 8 + 3] = a[3];
            v[i * 8 + 4] = c[0]; v[i * 8 + 5] = c[1]; v[i * 8 + 6] = c[2]; v[i * 8 + 7] = c[3];
        }
        float ss = 0.f;
#pragma unroll
        for (int j = 0; j < 16; ++j) ss += v[j] * v[j];
        ss = wave_sum(ss);
        const float rstd = rsqrtf(ss * (1.0f / 1024.0f) + EPS);
#pragma unroll
        for (int j = 0; j < 16; ++j) v[j] = v[j] * rstd * A[j] + B[j];
#pragma unroll
        for (int i = 0; i < 2; ++i) {
            unsigned w[4];
#pragma unroll
            for (int j = 0; j < 4; ++j) w[j] = pk_bf16(v[i * 8 + 2 * j], v[i * 8 + 2 * j + 1]);
            *(u32x4*)(Uo + (size_t)row * DM + 8 * lane + 512 * i) = (u32x4){w[0], w[1], w[2], w[3]};
        }
        int wo = 0; asm volatile("" : "+v"(wo));
        const LAS float* wrTo = wrT + wo;
        float lg[16];
#pragma unroll
        for (int e = 0; e < 16; ++e) {
            float s = 0.f;
#pragma unroll
            for (int i = 0; i < 2; ++i) {
                const f32x4 w0 = *(const LAS f32x4*)(wrTo + e * 1024 + 8 * lane + 512 * i), w1 = *(const LAS f32x4*)(wrTo + e * 1024 + 8 * lane + 512 * i + 4);
                s += v[i * 8 + 0] * w0[0] + v[i * 8 + 1] * w0[1] + v[i * 8 + 2] * w0[2] + v[i * 8 + 3] * w0[3];
                s += v[i * 8 + 4] * w1[0] + v[i * 8 + 5] * w1[1] + v[i * 8 + 6] * w1[2] + v[i * 8 + 7] * w1[3];
            }
            lg[e] = s;
        }
        float t8[8], t4[4], t2[2], t1;
        {
            const bool hi = lane & 1;
#pragma unroll
            for (int i = 0; i < 8; ++i) { const float keep = hi ? lg[2 * i + 1] : lg[2 * i], send = hi ? lg[2 * i] : lg[2 * i + 1]; t8[i] = keep + __shfl_xor(send, 1); }
        }
        {
            const bool hi = lane & 2;
#pragma unroll
            for (int i = 0; i < 4; ++i) { const float keep = hi ? t8[2 * i + 1] : t8[2 * i], send = hi ? t8[2 * i] : t8[2 * i + 1]; t4[i] = keep + __shfl_xor(send, 2); }
        }
        {
            const bool hi = lane & 4;
#pragma unroll
            for (int i = 0; i < 2; ++i) { const float keep = hi ? t4[2 * i + 1] : t4[2 * i], send = hi ? t4[2 * i] : t4[2 * i + 1]; t2[i] = keep + __shfl_xor(send, 4); }
        }
        {
            const bool hi = lane & 8;
            const float keep = hi ? t2[1] : t2[0], send = hi ? t2[0] : t2[1]; t1 = keep + __shfl_xor(send, 8);
        }
        t1 += __shfl_xor(t1, 16); t1 += __shfl_xor(t1, 32);
        float mx = t1;
        mx = fmaxf(mx, __shfl_xor(mx, 1)); mx = fmaxf(mx, __shfl_xor(mx, 2)); mx = fmaxf(mx, __shfl_xor(mx, 4)); mx = fmaxf(mx, __shfl_xor(mx, 8));
        const float ex = expf(t1 - mx);
        float sm = ex;
        sm += __shfl_xor(sm, 1); sm += __shfl_xor(sm, 2); sm += __shfl_xor(sm, 4); sm += __shfl_xor(sm, 8);
        if (lane < 16) AFFT[(size_t)lane * NT + row] = ex / sm;
    }
    __syncthreads();
}

__device__ __forceinline__ int block_suffix_incl(int v, LAS int* scr, int tid) {
    const int lane = tid & 63, wid = tid >> 6;
#pragma unroll
    for (int d = 1; d < 64; d <<= 1) { const int t = __shfl_down(v, d); if (lane + d < 64) v += t; }
    __syncthreads();
    if (lane == 0) scr[wid] = v;
    __syncthreads();
    int add = 0;
#pragma unroll
    for (int w = 0; w < 8; ++w) add += (w > wid) ? scr[w] : 0;
    return v + add;
}
__device__ __forceinline__ int block_prefix_incl(int v, LAS int* scr, int tid) {
    const int lane = tid & 63, wid = tid >> 6;
#pragma unroll
    for (int d = 1; d < 64; d <<= 1) { const int t = __shfl_up(v, d); if (lane >= d) v += t; }
    __syncthreads();
    if (lane == 63) scr[wid] = v;
    __syncthreads();
    int add = 0;
#pragma unroll
    for (int w = 0; w < 8; ++w) add += (w < wid) ? scr[w] : 0;
    return v + add;
}
template <int NB>
__device__ __forceinline__ int block_find_bin(LAS int* hist, LAS int* scr, int k, int& krem, int tid) {
    int loc = 0;
#pragma unroll
    for (int j = 0; j < NB; ++j) loc += hist[tid * NB + j];
    const int suf_incl = block_suffix_incl(loc, scr, tid), suf_excl = suf_incl - loc;
    if (suf_excl < k && suf_incl >= k) {
        int run = suf_excl;
#pragma unroll
        for (int j = NB - 1; j >= 0; --j) {
            const int h = hist[tid * NB + j];
            if (run < k && run + h >= k) { scr[16] = tid * NB + j; scr[17] = k - run; }
            run += h;
        }
    }
    __syncthreads();
    const int bin = scr[16];
    krem = scr[17];
    __syncthreads();
    return bin;
}
__device__ __forceinline__ void lds_inc(LAS int* p) { __hip_atomic_fetch_add(p, 1, __ATOMIC_RELAXED, __HIP_MEMORY_SCOPE_WORKGROUP); }

template <int LEN>
__device__ __forceinline__ void topk_item(LAS unsigned char* lds, const Params& P, int g, int e) {
    LAS int* hist = (LAS int*)lds;
    LAS int* scr = (LAS int*)(lds + 16384);
    const int tid = otid();
    constexpr int T = LEN * NTHREADS;
    const int t0 = g ? T0 : 0, cap = T >> 3, lo = tid * LEN;
    const u32x4* v4 = (const u32x4*)((const unsigned*)(P.ws + WS_AFFT) + (size_t)e * NT + t0 + lo);
#define TOPK_FOREACH(BODY) for (int ib = 0; ib < LEN / 16; ++ib) { u32x4 q_[4]; _Pragma("unroll") for (int u = 0; u < 4; ++u) q_[u] = v4[ib * 4 + u]; \
        _Pragma("unroll") for (int u = 0; u < 4; ++u) _Pragma("unroll") for (int j = 0; j < 4; ++j) { const unsigned x = q_[u][j]; const int idx = ib * 16 + u * 4 + j; (void)idx; BODY } }
    int k = cap, krem;
    for (int i = tid; i < 4096; i += NTHREADS) hist[i] = 0;
    __syncthreads();
    TOPK_FOREACH(lds_inc(&hist[x >> 20]);)
    __syncthreads();
    const unsigned p1 = (unsigned)block_find_bin<8>(hist, scr, k, krem, tid); k = krem;
    for (int i = tid; i < 4096; i += NTHREADS) hist[i] = 0;
    __syncthreads();
    TOPK_FOREACH(if ((x >> 20) == p1) lds_inc(&hist[(x >> 8) & 4095]);)
    __syncthreads();
    const unsigned p2 = (unsigned)block_find_bin<8>(hist, scr, k, krem, tid); k = krem;
    hist[tid] = 0;
    __syncthreads();
    const unsigned p12 = (p1 << 12) | p2;
    TOPK_FOREACH(if ((x >> 8) == p12) lds_inc(&hist[x & 255]);)
    __syncthreads();
    const unsigned p3 = (unsigned)block_find_bin<1>(hist, scr, k, krem, tid);
    const unsigned thr = (p12 << 8) | p3;
    const int keq = krem;
    int cg_ = 0, ce = 0;
    TOPK_FOREACH(cg_ += x > thr; ce += x == thr;)
    int gt_run = block_prefix_incl(cg_, scr, tid) - cg_;
    int eq_run = block_prefix_incl(ce, scr, tid) - ce;
    int* TOKOF = (int*)(P.ws + WS_TOKOF);
    float* GVAL = (float*)(P.ws + WS_GVAL);
    int* SLOTOF = (int*)(P.ws + WS_SLOTOF);
    const int rbase = e * ROWS_E + (g ? 8192 : 0);
    TOPK_FOREACH(
        const bool isg = x > thr; const bool ise = x == thr;
        const bool sel = isg || (ise && eq_run < keq);
        const int slot = gt_run + min(eq_run, keq);
        const int trow = t0 + lo + idx;
        if (sel) { TOKOF[rbase + slot] = trow; GVAL[rbase + slot] = __uint_as_float(x); }
        SLOTOF[(size_t)trow * 16 + e] = sel ? rbase + slot : -1;
        gt_run += isg; eq_run += ise;)
#undef TOPK_FOREACH
    __syncthreads();
}
__device__ __forceinline__ void phase_topk_item(LAS unsigned char* lds, const Params& P, int item) {
    if (item < 16) topk_item<128>(lds, P, 0, item); else topk_item<32>(lds, P, 1, item - 16);
}

__device__ __forceinline__ void phase_final(const Params& P) {
    const int tid_ = otid();
    const int lane = tid_ & 63, gw = blockIdx.x * 8 + (tid_ >> 6), nw = gridDim.x * 8;
    const float* MOD = (const float*)(P.ws + WS_MOD);
    const int* SLOTOF = (const int*)(P.ws + WS_SLOTOF);
    const bf16_t* YE = (const bf16_t*)(P.ws + WS_YE);
    float wf[16];
#pragma unroll
    for (int i = 0; i < 2; ++i)
#pragma unroll
        for (int j = 0; j < 8; ++j) wf[i * 8 + j] = P.in[I_NFW][8 * lane + 512 * i + j];
    for (int row = gw; row < NT; row += nw) {
        const int b = batch_of_row(row);
        float* xr = P.out + (size_t)row * DM;
        float v[16], acc[16];
#pragma unroll
        for (int i = 0; i < 2; ++i) {
            const f32x4 a = *(const f32x4*)(xr + 8 * lane + 512 * i), c = *(const f32x4*)(xr + 8 * lane + 512 * i + 4);
            v[i * 8 + 0] = a[0]; v[i * 8 + 1] = a[1]; v[i * 8 + 2] = a[2]; v[i * 8 + 3] = a[3];
            v[i * 8 + 4] = c[0]; v[i * 8 + 5] = c[1]; v[i * 8 + 6] = c[2]; v[i * 8 + 7] = c[3];
        }
#pragma unroll
        for (int j = 0; j < 16; ++j) acc[j] = 0.f;
        const int myslot = SLOTOF[(size_t)row * 16 + (lane & 15)];
        for (int e = 0; e < 16; ++e) {
            const int s = __shfl(myslot, e);
            if (s >= 0) {
#pragma unroll
                for (int i = 0; i < 2; ++i) {
                    const u32x4 y = *(const u32x4*)(YE + (size_t)s * DM + 8 * lane + 512 * i);
#pragma unroll
                    for (int j = 0; j < 4; ++j) { acc[i * 8 + 2 * j] += bf_lo(y[j]); acc[i * 8 + 2 * j + 1] += bf_hi(y[j]); }
                }
            }
        }
        float ss = 0.f;
#pragma unroll
        for (int i = 0; i < 2; ++i)
#pragma unroll
            for (int j = 0; j < 8; ++j) {
                const float g2 = MOD[b * 6144 + 5120 + 8 * lane + 512 * i + j];
                v[i * 8 + j] += g2 * acc[i * 8 + j];
                ss += v[i * 8 + j] * v[i * 8 + j];
            }
        ss = wave_sum(ss);
        const float rstd = rsqrtf(ss * (1.0f / 1024.0f) + EPS);
#pragma unroll
        for (int i = 0; i < 2; ++i) {
            *(f32x4*)(xr + 8 * lane + 512 * i) = (f32x4){v[i * 8 + 0] * rstd * wf[i * 8 + 0], v[i * 8 + 1] * rstd * wf[i * 8 + 1], v[i * 8 + 2] * rstd * wf[i * 8 + 2], v[i * 8 + 3] * rstd * wf[i * 8 + 3]};
            *(f32x4*)(xr + 8 * lane + 512 * i + 4) = (f32x4){v[i * 8 + 4] * rstd * wf[i * 8 + 4], v[i * 8 + 5] * rstd * wf[i * 8 + 5], v[i * 8 + 6] * rstd * wf[i * 8 + 6], v[i * 8 + 7] * rstd * wf[i * 8 + 7]};
        }
    }
}

__device__ __forceinline__ void phase_glaprep(LAS unsigned char* lds, const Params& P) {
    const int tid = otid();
    const float* LR = (const float*)(P.ws + WS_LR);
    unsigned* EQ = (unsigned*)(P.ws + WS_S5);
    LAS float* lrs = (LAS float*)lds;
    const int dir = tid >> 8, col = 2 * (tid & 255);
    float wa[16][2], bias[2];
    {
        const float* w = P.in[dir ? I_WAB : I_WAF] + col;
#pragma unroll
        for (int r = 0; r < 16; ++r) { const f32x2 t = *(const f32x2*)(w + r * 512); wa[r][0] = t[0]; wa[r][1] = t[1]; }
        const f32x2 t = *(const f32x2*)(P.in[dir ? I_BAB : I_BAF] + col);
        bias[0] = t[0]; bias[1] = t[1];
    }
    for (int ch = blockIdx.x; ch < NT / 64; ch += gridDim.x) {
        const int rc = ch * 64;
        __syncthreads();
        *(LAS f32x4*)(lrs + tid * 4) = *(const f32x4*)(LR + (size_t)rc * 32 + tid * 4);
        __syncthreads();
        float c0 = 0.f, c1 = 0.f;
        for (int ii = 0; ii < 64; ++ii) {
            const int tok = dir ? 63 - ii : ii;
            const LAS f32x4* lp = (const LAS f32x4*)(lrs + tok * 32 + dir * 16);
            float x0 = bias[0], x1 = bias[1];
#pragma unroll
            for (int r4 = 0; r4 < 4; ++r4) {
                const f32x4 l = lp[r4];
#pragma unroll
                for (int r = 0; r < 4; ++r) { x0 += l[r] * wa[r4 * 4 + r][0]; x1 += l[r] * wa[r4 * 4 + r][1]; }
            }
            c0 += (fminf(x0, 0.f) - __logf(1.0f + __expf(-fabsf(x0)))) * 0.0625f;
            c1 += (fminf(x1, 0.f) - __logf(1.0f + __expf(-fabsf(x1)))) * 0.0625f;
            EQ[((size_t)(rc + tok) * 1024 + dir * 512 + col) >> 1] = pk_bf16(__expf(c0), __expf(c1));
        }
    }
    __syncthreads();
}

constexpr int G_DEC = 0, G_QT = 512, G_KT = G_QT + 17408, G_KET = G_KT + 17408, G_VT = G_KET + 18432, G_ATT = G_VT + 18432, G_ST = G_ATT + 9216;
static_assert(G_ST + 34816 <= LDS_BYTES, "gla lds");

struct GlaRegs { unsigned q2[8], k2[8], e2[8], ed; u32x4 vv[2]; };

__device__ __forceinline__ void gla_item(LAS unsigned char* lds, const Params& P, int seq, int head, int dir, int vs) {
    const int tid = otid(), wid = tid >> 6, lane = tid & 63;
    const int r0 = seq < 16 ? seq * 4096 : T0 + (seq - 16) * 8192, L = seq < 16 ? 4096 : 8192, nch = L >> 6;
    const int p = lane, tg = wid;
    const unsigned char* QK = P.ws + WS_S1;
    const unsigned char* V = P.ws + WS_S2;
    const unsigned char* EQ = P.ws + WS_S5;
    unsigned char* O = (unsigned char*)P.out + (dir ? U : 0);
    f32x16 Sacc[2];
#pragma unroll
    for (int t = 0; t < 2; ++t)
#pragma unroll
        for (int i = 0; i < 16; ++i) Sacc[t][i] = 0.f;
    auto load_chunk = [&](GlaRegs& R, int step) {
        const int ci = dir ? nch - 1 - step : step, rc = r0 + ci * 64;
#pragma unroll
        for (int i = 0; i < 8; ++i) {
            const size_t row = (size_t)(rc + 8 * tg + i) * 2048;
            R.q2[i] = *(const unsigned*)(QK + row + (head * 128 + 2 * p) * 2);
            R.k2[i] = *(const unsigned*)(QK + row + 1024 + (head * 128 + 2 * p) * 2);
            R.e2[i] = *(const unsigned*)(EQ + row + (dir * 512 + head * 128 + 2 * p) * 2);
        }
        R.ed = *(const unsigned*)(EQ + (size_t)(rc + (dir ? 0 : 63)) * 2048 + (dir * 512 + head * 128 + 2 * p) * 2);
        const unsigned char* vp = V + (size_t)(rc + (tid >> 3)) * 2048 + (head * 256 + vs * 128 + (tid & 7) * 16) * 2;
        R.vv[0] = *(const u32x4*)vp; R.vv[1] = *(const u32x4*)(vp + 16);
    };
    const int mi = wid >> 1, c31 = lane & 31, hh = lane >> 5, l15 = lane & 15, l4 = lane >> 4;
    LAS unsigned char* ST = lds + G_ST;
    auto do_step = [&](GlaRegs& R, int step) {
        const int ci = dir ? nch - 1 - step : step, rc = r0 + ci * 64;
        for (int repa = 0; repa < REPA; ++repa) { asm volatile("" ::: "memory");
#pragma unroll
        for (int t = 0; t < 2; ++t) {
            const int ni = (wid & 1) * 2 + t;
#pragma unroll
            for (int g = 0; g < 4; ++g)
                *(LAS u32x2*)(ST + (32 * ni + c31) * 272 + (32 * mi + 8 * g + 4 * hh) * 2) = (u32x2){pk_bf16(Sacc[t][4 * g], Sacc[t][4 * g + 1]), pk_bf16(Sacc[t][4 * g + 2], Sacc[t][4 * g + 3])};
        }
        {
            const float dec0 = bf_lo(R.ed), dec1 = bf_hi(R.ed);
            unsigned ke0[4], ke1[4];
            float pe0 = 0.f, pe1 = 0.f;
#pragma unroll
            for (int i = 0; i < 8; ++i) {
                const float eq0 = bf_lo(R.e2[i]), eq1 = bf_hi(R.e2[i]);
                const float ek0 = __builtin_amdgcn_rcpf(eq0), ek1 = __builtin_amdgcn_rcpf(eq1);
                const float kl = bf_lo(R.k2[i]) * ek0, kh = bf_hi(R.k2[i]) * ek1;
                const int tok = 8 * tg + i;
                *(LAS unsigned*)(lds + G_QT + tok * 272 + 4 * p) = pk_bf16(bf_lo(R.q2[i]) * eq0, bf_hi(R.q2[i]) * eq1);
                *(LAS unsigned*)(lds + G_KT + tok * 272 + 4 * p) = pk_bf16(kl, kh);
                const float e0 = kl * dec0, e1 = kh * dec1;
                if (i & 1) { ke0[i >> 1] = pk_bf16(pe0, e0); ke1[i >> 1] = pk_bf16(pe1, e1); } else { pe0 = e0; pe1 = e1; }
            }
            *(LAS u32x4*)(lds + G_KET + (2 * p) * 144 + 16 * tg) = (u32x4){ke0[0], ke0[1], ke0[2], ke0[3]};
            *(LAS u32x4*)(lds + G_KET + (2 * p + 1) * 144 + 16 * tg) = (u32x4){ke1[0], ke1[1], ke1[2], ke1[3]};
            if (tg == 0) *(LAS f32x2*)(lds + G_DEC + 8 * p) = (f32x2){dec0, dec1};
        }
        {
            const int tok = tid >> 3, seg = tid & 7;
#pragma unroll
            for (int h2 = 0; h2 < 2; ++h2)
#pragma unroll
                for (int j = 0; j < 4; ++j) {
                    *(LAS unsigned short*)(lds + G_VT + (seg * 16 + h2 * 8 + 2 * j) * 144 + ((tok ^ (8 * seg)) * 2)) = (unsigned short)(R.vv[h2][j] & 0xffffu);
                    *(LAS unsigned short*)(lds + G_VT + (seg * 16 + h2 * 8 + 2 * j + 1) * 144 + ((tok ^ (8 * seg)) * 2)) = (unsigned short)(R.vv[h2][j] >> 16);
                }
        }
        }
        if (step + 2 < nch) load_chunk(R, step + 2);
        __syncthreads();
        {
            const int ti = wid >> 1;
#pragma unroll
            for (int tt = 0; tt < 2; ++tt) {
                const int tj = (wid & 1) * 2 + tt;
                f32x4 a4 = {0.f, 0.f, 0.f, 0.f};
                const bool skip = dir == 0 ? (tj > ti) : (tj < ti);
                if (!skip) {
#pragma unroll
                    for (int kk = 0; kk < 4; ++kk) {
                        const bf16x8 X = *(const LAS bf16x8*)(lds + G_KT + (tj * 16 + l15) * 272 + (kk * 32 + l4 * 8) * 2);
                        const bf16x8 Y = *(const LAS bf16x8*)(lds + G_QT + (ti * 16 + l15) * 272 + (kk * 32 + l4 * 8) * 2);
                        a4 = __builtin_amdgcn_mfma_f32_16x16x32_bf16(X, Y, a4, 0, 0, 0);
                    }
                }
                const int i = ti * 16 + l15, j0 = tj * 16 + 4 * l4;
#pragma unroll
                for (int r = 0; r < 4; ++r) { const bool keep = dir == 0 ? (j0 + r <= i) : (j0 + r >= i); a4[r] = keep ? a4[r] : 0.f; }
                *(LAS u32x2*)(lds + G_ATT + i * 144 + j0 * 2) = (u32x2){pk_bf16(a4[0], a4[1]), pk_bf16(a4[2], a4[3])};
            }
        }
        __syncthreads();
        {
            const int ti = wid >> 1;
            bf16x8 Ya[2], Yq[4];
#pragma unroll
            for (int kk = 0; kk < 2; ++kk) Ya[kk] = *(const LAS bf16x8*)(lds + G_ATT + (ti * 16 + l15) * 144 + (kk * 32 + l4 * 8) * 2);
#pragma unroll
            for (int kk = 0; kk < 4; ++kk) Yq[kk] = *(const LAS bf16x8*)(lds + G_QT + (ti * 16 + l15) * 272 + (kk * 32 + l4 * 8) * 2);
#pragma unroll
            for (int tt = 0; tt < 4; ++tt) {
                const int tn = (wid & 1) * 4 + tt;
                f32x4 a4 = {0.f, 0.f, 0.f, 0.f};
#pragma unroll
                for (int kk = 0; kk < 2; ++kk) {
                    const bf16x8 X = *(const LAS bf16x8*)(lds + G_VT + (tn * 16 + l15) * 144 + (((kk * 4 + l4) ^ tn) * 16));
                    a4 = __builtin_amdgcn_mfma_f32_16x16x32_bf16(X, Ya[kk], a4, 0, 0, 0);
                }
#pragma unroll
                for (int kk = 0; kk < 4; ++kk) {
                    const bf16x8 X = *(const LAS bf16x8*)(ST + (tn * 16 + l15) * 272 + (kk * 32 + l4 * 8) * 2);
                    a4 = __builtin_amdgcn_mfma_f32_16x16x32_bf16(X, Yq[kk], a4, 0, 0, 0);
                }
                const int tok = ti * 16 + l15, dv = tn * 16 + 4 * l4;
                *(u32x2*)(O + (size_t)(rc + tok) * 2048 + (head * 256 + vs * 128 + dv) * 2) = (u32x2){pk_bf16(a4[0], a4[1]), pk_bf16(a4[2], a4[3])};
            }
            bf16x8 Ak[4];
#pragma unroll
            for (int kk = 0; kk < 4; ++kk) Ak[kk] = *(const LAS bf16x8*)(lds + G_KET + (32 * mi + c31) * 144 + (16 * kk + 8 * hh) * 2);
#pragma unroll
            for (int g = 0; g < 4; ++g) {
                const f32x4 d4 = *(const LAS f32x4*)(lds + G_DEC + (32 * mi + 8 * g + 4 * hh) * 4);
#pragma unroll
                for (int r = 0; r < 4; ++r) { Sacc[0][4 * g + r] *= d4[r]; Sacc[1][4 * g + r] *= d4[r]; }
            }
#pragma unroll
            for (int t = 0; t < 2; ++t) {
                const int ni = (wid & 1) * 2 + t;
#pragma unroll
                for (int kk = 0; kk < 4; ++kk) {
                    const bf16x8 B = *(const LAS bf16x8*)(lds + G_VT + (32 * ni + c31) * 144 + (((2 * kk + hh) ^ (2 * ni + (c31 >> 4))) * 16));
                    Sacc[t] = __builtin_amdgcn_mfma_f32_32x32x16_bf16(Ak[kk], B, Sacc[t], 0, 0, 0);
                }
            }
        }
        __syncthreads();
    };
    GlaRegs RA, RB;
    load_chunk(RA, 0);
    load_chunk(RB, 1);
    for (int step = 0; step < nch; step += 2) {
        do_step(RA, step);
        do_step(RB, step + 1);
    }
}

__device__ __forceinline__ void phase_gla(LAS unsigned char* lds, const Params& P) {
    const int b = blockIdx.x, G = gridDim.x;
    for (int k = 0; k < 16; ++k) {
        int it = -1;
        if (G == 256) {
            if (b < 32) it = k == 0 ? b : -1;
            else { const int s = (b - 32) + 224 * k; it = s < 256 ? 32 + s : -1; }
        } else { it = b + G * k; if (it >= 288) it = -1; }
        if (it < 0) break;
        int seq, rest;
        if (it < 32) { seq = 16 + (it >> 4); rest = it & 15; } else { seq = (it - 32) >> 4; rest = (it - 32) & 15; }
        gla_item(lds, P, seq, rest >> 2, (rest >> 1) & 1, rest & 1);
    }
}

constexpr int BM = 256, BK = 64, HALF = 128, HTB = HALF * BK * 2, NXCD = 8, WGM = 8;
__device__ __forceinline__ int lds_byte(int r, int c) { const int st = (r >> 4) * 2 + (c >> 5), rr = r & 15, cc = c & 31, ob = rr * 64 + cc * 2; return st * 1024 + (ob ^ (((ob >> 9) & 1) << 5)); }
__device__ __forceinline__ void stage_rc(int b, int& R, int& C) { const int st = b / 1024, sb = b % 1024, swz = sb ^ (((sb >> 9) & 1) << 5); R = (st >> 1) * 16 + swz / 64; C = (st & 1) * 32 + (swz % 64) / 2; }
__device__ __forceinline__ int perm32(int rho) { const int n = rho >> 4, i = rho & 15; return 8 * (i >> 2) + 4 * n + (i & 3); }

enum { T_G1 = 0, T_G1B, T_G2, T_G3, T_G4, T_GU, T_DN };

template <int TY>
__device__ __forceinline__ bool unit_next(int i, int bid, int& pm, int& pn) {
    constexpr int nM = (TY == T_GU || TY == T_DN) ? 160 : 320;
    constexpr int nN = TY == T_G1 ? 21 : TY == T_G1B ? 12 : TY == T_GU ? 22 : 4;
    constexpr int nwg = nM * nN;
    const long L = (long)i * gridDim.x + bid;
    if (L >= nwg) return false;
    int wgid = (int)L;
    { const int q = nwg / NXCD, r = nwg % NXCD, xcd = wgid % NXCD, off = wgid / NXCD; wgid = (xcd < r ? xcd * (q + 1) : r * (q + 1) + (xcd - r) * q) + off; }
    const int nig = WGM * nN, gid = wgid / nig, fm = gid * WGM, gsz = (nM - fm) < WGM ? (nM - fm) : WGM;
    pm = fm + ((wgid % nig) % gsz); pn = (wgid % nig) / gsz;
    return true;
}

template <int TY>
__device__ __forceinline__ void gemm_epilogue(const f32x4 (&acc)[2][2][4][2], const Params& P, int batch, int pm, int pn, int wr, int wc, int fr, int fq) {
    const int row0 = pm * 256 + wr * 64 + fr;
    const int cl0 = wc * 32 + 8 * fq;
    if constexpr (TY == T_G1) {
        if (pn < 12) {
            bf16_t* base = (bf16_t*)(P.ws + WS_S1 + (size_t)(pn >> 2) * U) + (pn & 3) * 256 + cl0;
#pragma unroll
            for (int ai = 0; ai < 2; ++ai)
#pragma unroll
                for (int m = 0; m < 4; ++m)
#pragma unroll
                    for (int bj = 0; bj < 2; ++bj) {
                        const f32x4 v0 = acc[ai][bj][m][0], v1 = acc[ai][bj][m][1];
                        *(u32x4*)(base + (size_t)(row0 + ai * 128 + m * 16) * DM + bj * 128) = (u32x4){pk_bf16(v0[0], v0[1]), pk_bf16(v0[2], v0[3]), pk_bf16(v1[0], v1[1]), pk_bf16(v1[2], v1[3])};
                    }
        } else if (pn == 12) {
            if (wc == 0) {
                float* LR = (float*)(P.ws + WS_LR);
#pragma unroll
                for (int ai = 0; ai < 2; ++ai)
#pragma unroll
                    for (int m = 0; m < 4; ++m) {
                        float* d = LR + (size_t)(row0 + ai * 128 + m * 16) * 32 + 8 * fq;
                        *(f32x4*)d = acc[ai][0][m][0]; *(f32x4*)(d + 4) = acc[ai][0][m][1];
                    }
            }
        } else {
            bf16_t* base = (bf16_t*)(P.ws + WS_S4) + (pn - 13) * 128 + cl0;
#pragma unroll
            for (int ai = 0; ai < 2; ++ai)
#pragma unroll
                for (int m = 0; m < 4; ++m) {
                    const f32x4 v0 = acc[ai][0][m][0] * acc[ai][1][m][0], v1 = acc[ai][0][m][1] * acc[ai][1][m][1];
                    *(u32x4*)(base + (size_t)(row0 + ai * 128 + m * 16) * DM) = (u32x4){pk_bf16(v0[0], v0[1]), pk_bf16(v0[2], v0[3]), pk_bf16(v1[0], v1[1]), pk_bf16(v1[2], v1[3])};
                }
        }
    } else if constexpr (TY == T_G1B) {
        if (pn < 4) {
            const bf16_t* XC = (const bf16_t*)(P.ws + WS_S4);
            bf16_t* OBp = (bf16_t*)(P.ws + WS_S2);
#pragma unroll
            for (int bj = 0; bj < 2; ++bj)
#pragma unroll
                for (int n = 0; n < 2; ++n) {
                    const int col = pn * 256 + bj * 128 + cl0 + 4 * n;
                    const f32x4 w0 = *(const f32x4*)(P.in[I_CW] + col), w1 = *(const f32x4*)(P.in[I_CW] + 1024 + col), w2 = *(const f32x4*)(P.in[I_CW] + 2048 + col), cb = *(const f32x4*)(P.in[I_CB] + col);
#pragma unroll
                    for (int ai = 0; ai < 2; ++ai)
#pragma unroll
                        for (int m = 0; m < 4; ++m) {
                            const int row = row0 + ai * 128 + m * 16;
                            const int lm = row < T0 ? 4095 : 8191, pos = row & lm;
                            const u32x2 z = {0u, 0u};
                            const u32x2 xm = pos == 0 ? z : *(const u32x2*)(XC + (size_t)(row - 1) * DM + col);
                            const u32x2 x0 = *(const u32x2*)(XC + (size_t)row * DM + col);
                            const u32x2 xp = pos == lm ? z : *(const u32x2*)(XC + (size_t)(row + 1) * DM + col);
                            const f32x4 v = acc[ai][bj][m][n];
                            const float c0 = bf_lo(xm[0]) * w0[0] + bf_lo(x0[0]) * w1[0] + bf_lo(xp[0]) * w2[0] + cb[0];
                            const float c1 = bf_hi(xm[0]) * w0[1] + bf_hi(x0[0]) * w1[1] + bf_hi(xp[0]) * w2[1] + cb[1];
                            const float c2 = bf_lo(xm[1]) * w0[2] + bf_lo(x0[1]) * w1[2] + bf_lo(xp[1]) * w2[2] + cb[2];
                            const float c3 = bf_hi(xm[1]) * w0[3] + bf_hi(x0[1]) * w1[3] + bf_hi(xp[1]) * w2[3] + cb[3];
                            *(u32x2*)(OBp + (size_t)row * DM + col) = (u32x2){pk_bf16(v[0] * c0, v[1] * c1), pk_bf16(v[2] * c2, v[3] * c3)};
                        }
                }
        } else {
            bf16_t* base = (bf16_t*)(P.ws + (pn < 8 ? WS_S3 : WS_S5)) + (pn & 3) * 256 + cl0;
#pragma unroll
            for (int ai = 0; ai < 2; ++ai)
#pragma unroll
                for (int m = 0; m < 4; ++m)
#pragma unroll
                    for (int bj = 0; bj < 2; ++bj) {
                        const f32x4 v0 = acc[ai][bj][m][0], v1 = acc[ai][bj][m][1];
                        *(u32x4*)(base + (size_t)(row0 + ai * 128 + m * 16) * DM + bj * 128) =
                            (u32x4){pk_bf16(fast_sigmoid(v0[0]), fast_sigmoid(v0[1])), pk_bf16(fast_sigmoid(v0[2]), fast_sigmoid(v0[3])), pk_bf16(fast_sigmoid(v1[0]), fast_sigmoid(v1[1])), pk_bf16(fast_sigmoid(v1[2]), fast_sigmoid(v1[3]))};
                    }
        }
    } else if constexpr (TY == T_G2 || TY == T_G3) {
        bf16_t* M3 = (bf16_t*)(P.ws + WS_S3) + pn * 256 + cl0;
        bf16_t* M5 = (bf16_t*)(P.ws + WS_S5) + pn * 256 + cl0;
#pragma unroll
        for (int ai = 0; ai < 2; ++ai)
#pragma unroll
            for (int m = 0; m < 4; ++m)
#pragma unroll
                for (int bj = 0; bj < 2; ++bj) {
                    const size_t o = (size_t)(row0 + ai * 128 + m * 16) * DM + bj * 128;
                    const f32x4 v0 = acc[ai][bj][m][0], v1 = acc[ai][bj][m][1];
                    if constexpr (TY == T_G2) {
                        const u32x4 g = *(const u32x4*)(M3 + o);
                        *(u32x4*)(M3 + o) = (u32x4){pk_bf16(v0[0] * bf_lo(g[0]), v0[1] * bf_hi(g[0])), pk_bf16(v0[2] * bf_lo(g[1]), v0[3] * bf_hi(g[1])), pk_bf16(v1[0] * bf_lo(g[2]), v1[1] * bf_hi(g[2])), pk_bf16(v1[2] * bf_lo(g[3]), v1[3] * bf_hi(g[3]))};
                    } else {
                        const u32x4 g = *(const u32x4*)(M5 + o), a = *(const u32x4*)(M3 + o);
                        *(u32x4*)(M5 + o) = (u32x4){pk_bf16(bf_lo(a[0]) + v0[0] * bf_lo(g[0]), bf_hi(a[0]) + v0[1] * bf_hi(g[0])), pk_bf16(bf_lo(a[1]) + v0[2] * bf_lo(g[1]), bf_hi(a[1]) + v0[3] * bf_hi(g[1])),
                                                    pk_bf16(bf_lo(a[2]) + v1[0] * bf_lo(g[2]), bf_hi(a[2]) + v1[1] * bf_hi(g[2])), pk_bf16(bf_lo(a[3]) + v1[2] * bf_lo(g[3]), bf_hi(a[3]) + v1[3] * bf_hi(g[3]))};
                    }
                }
    } else if constexpr (TY == T_G4) {
        const float* MOD = (const float*)(P.ws + WS_MOD);
#pragma unroll
        for (int ai = 0; ai < 2; ++ai)
#pragma unroll
            for (int m = 0; m < 4; ++m) {
                const int row = row0 + ai * 128 + m * 16;
                const float* xr = x_row(P, row);
                const float* g1 = MOD + batch_of_row(row) * 6144 + 2048;
#pragma unroll
                for (int bj = 0; bj < 2; ++bj) {
                    const int col = pn * 256 + bj * 128 + cl0;
#pragma unroll
                    for (int n = 0; n < 2; ++n) {
                        const f32x4 xv = *(const f32x4*)(xr + col + 4 * n), gv = *(const f32x4*)(g1 + col + 4 * n);
                        *(f32x4*)(P.out + (size_t)row * DM + col + 4 * n) = xv + gv * acc[ai][bj][m][n];
                    }
                }
            }
    } else if constexpr (TY == T_GU) {
        bf16_t* Hh = (bf16_t*)(P.ws + WS_H) + pn * 128 + cl0;
#pragma unroll
        for (int ai = 0; ai < 2; ++ai)
#pragma unroll
            for (int m = 0; m < 4; ++m) {
                float h[8];
#pragma unroll
                for (int n = 0; n < 2; ++n)
#pragma unroll
                    for (int j = 0; j < 4; ++j) { const float gt = acc[ai][0][m][n][j]; h[4 * n + j] = gt * fast_sigmoid(gt) * acc[ai][1][m][n][j]; }
                *(u32x4*)(Hh + (size_t)(row0 + ai * 128 + m * 16) * DE) = (u32x4){pk_bf16(h[0], h[1]), pk_bf16(h[2], h[3]), pk_bf16(h[4], h[5]), pk_bf16(h[6], h[7])};
            }
    } else if constexpr (TY == T_DN) {
        const float* GV = (const float*)(P.ws + WS_GVAL) + (size_t)batch * ROWS_B;
        bf16_t* YE = (bf16_t*)(P.ws + WS_YE) + (size_t)batch * ROWS_B * DM + pn * 256 + cl0;
#pragma unroll
        for (int ai = 0; ai < 2; ++ai)
#pragma unroll
            for (int m = 0; m < 4; ++m) {
                const int row = row0 + ai * 128 + m * 16;
                const float g = GV[row];
#pragma unroll
                for (int bj = 0; bj < 2; ++bj) {
                    const f32x4 v0 = acc[ai][bj][m][0] * g, v1 = acc[ai][bj][m][1] * g;
                    *(u32x4*)(YE + (size_t)row * DM + bj * 128) = (u32x4){pk_bf16(v0[0], v0[1]), pk_bf16(v0[2], v0[3]), pk_bf16(v1[0], v1[1]), pk_bf16(v1[2], v1[3])};
                }
            }
    }
}

template <int TY>
__device__ __forceinline__ void gemm_phase(LAS unsigned char* lds, const Params& P, int batch) {
    constexpr int K = TY == T_DN ? DE : DM, nt = K / BK;
    constexpr bool GATHER = TY == T_GU;
    const int tid = otid(), wid = __builtin_amdgcn_readfirstlane(tid >> 6), lane = tid & 63, wr = wid >> 2, wc = wid & 3, fr = lane & 15, fq = lane >> 4;
    const unsigned char* Abase = P.ws + (TY == T_G1 || TY == T_G1B ? WS_S0 : TY == T_G2 ? WS_S1 : TY == T_G3 ? WS_S2 : TY == T_G4 ? WS_S5 : TY == T_GU ? WS_S0 : WS_H);
    const unsigned char* Bbase = P.ws + (TY == T_G1 ? WS_WB1 : TY == T_G1B ? WS_WB1 + (size_t)5376 * 1024 * 2 : TY == T_G2 ? WS_WBA : TY == T_G3 ? WS_WBB : TY == T_G4 ? WS_WBO : TY == T_GU ? WS_WGU : WS_WDN);
    const int* TOK = (const int*)(P.ws + WS_TOKOF) + (size_t)batch * ROWS_B;
    constexpr size_t tstep = (size_t)256 * K * 2, hstepB = (size_t)128 * K * 2, kstep = BK * 2;
    int Rs[2], Cs[2];
    unsigned voffB[2], voffA[2][2], voffAn[2][2];
    constexpr size_t hstepA = GATHER ? 0 : (size_t)128 * K * 2;
#pragma unroll
    for (int i = 0; i < 2; ++i) {
        stage_rc(tid * 16 + i * 8192, Rs[i], Cs[i]);
        const int Rb = (Rs[i] & ~31) + perm32(Rs[i] & 31);
        voffB[i] = (unsigned)(Rb * K + Cs[i]) * 2u;
#pragma unroll
        for (int h = 0; h < 2; ++h) voffA[h][i] = voffAn[h][i] = (unsigned)(Rs[i] * K + Cs[i]) * 2u;
    }
    auto a_ptr = [&](int pm) -> const unsigned char* { return GATHER ? Abase : Abase + (size_t)pm * tstep; };
    auto b_ptr = [&](int pm, int pn) -> const unsigned char* {
        if constexpr (TY == T_GU) return Bbase + (size_t)((batch * 160 + pm) / 40) * 5632 * 1024 * 2 + (size_t)pn * tstep;
        else if constexpr (TY == T_DN) return Bbase + (size_t)((batch * 160 + pm) / 40) * 1024 * DE * 2 + (size_t)pn * tstep;
        else return Bbase + (size_t)pn * tstep;
    };
    auto gather_off = [&](int pm, unsigned (&vo)[2][2]) {
#pragma unroll
        for (int h = 0; h < 2; ++h)
#pragma unroll
            for (int i = 0; i < 2; ++i) vo[h][i] = (unsigned)TOK[pm * 256 + h * 128 + Rs[i]] * 2048u + (unsigned)Cs[i] * 2u;
    };
    const unsigned ldsw = (unsigned)wid * 1024u;
    const int aoff = lds_byte(wr * 64 + fr, fq * 8), boff = lds_byte(wc * 32 + fr, fq * 8);
#define G_SA(b, h) (((b) * 2 + (h)) * HTB)
#define G_SB(b, h) ((4 + (b) * 2 + (h)) * HTB)
#define G_STAGE(bufoff, gbase, v0, v1) do { \
        __builtin_amdgcn_global_load_lds((const unsigned*)((gbase) + (v0)), (LAS unsigned*)(lds + (bufoff) + ldsw), 16, 0, 0); \
        __builtin_amdgcn_global_load_lds((const unsigned*)((gbase) + (v1)), (LAS unsigned*)(lds + (bufoff) + ldsw + 8192), 16, 0, 0); } while (0)
#define G_LDA(dst, b, h) do { _Pragma("unroll") for (int m = 0; m < 4; ++m) _Pragma("unroll") for (int k = 0; k < 2; ++k) dst[m][k] = *(const LAS bf16x8*)(lds + G_SA(b, h) + aoff + m * 2048 + k * 1024); } while (0)
#define G_LDB(dst, b, h) do { _Pragma("unroll") for (int n = 0; n < 2; ++n) _Pragma("unroll") for (int k = 0; k < 2; ++k) dst[n][k] = *(const LAS bf16x8*)(lds + G_SB(b, h) + boff + n * 2048 + k * 1024); } while (0)
#define G_MMA(ai, bj, At, Bt) do { __builtin_amdgcn_s_setprio(1); _Pragma("unroll") for (int m = 0; m < 4; ++m) _Pragma("unroll") for (int n = 0; n < 2; ++n) _Pragma("unroll") for (int k = 0; k < 2; ++k) \
        acc[ai][bj][m][n] = __builtin_amdgcn_mfma_f32_16x16x32_bf16(Bt[n][k], At[m][k], acc[ai][bj][m][n], 0, 0, 0); __builtin_amdgcn_s_setprio(0); } while (0)
#define G_WAIT_V(n) asm volatile("s_waitcnt vmcnt(" #n ")" ::: "memory")
#define G_WAIT_L(n) asm volatile("s_waitcnt lgkmcnt(" #n ")" ::: "memory")
#define G_BAR __builtin_amdgcn_s_barrier()
#define G_SCHED __builtin_amdgcn_sched_barrier(0)
    int cpm, cpn, npm = 0, npn = 0, ui = 0;
    int bid = blockIdx.x; asm volatile("" : "+v"(bid)); bid = __builtin_amdgcn_readfirstlane(bid);
    if (!unit_next<TY>(0, bid, cpm, cpn)) return;
    f32x4 acc[2][2][4][2];
#pragma unroll
    for (int a = 0; a < 2; ++a)
#pragma unroll
        for (int b = 0; b < 2; ++b)
#pragma unroll
            for (int m = 0; m < 4; ++m)
#pragma unroll
                for (int n = 0; n < 2; ++n) acc[a][b][m][n] = (f32x4){0.f, 0.f, 0.f, 0.f};
    bf16x8 At[4][2], B0[2][2], B1[2][2];
    const unsigned char* cA = a_ptr(cpm);
    const unsigned char* cB = b_ptr(cpm, cpn);
    if constexpr (GATHER) gather_off(cpm, voffA);
    G_STAGE(G_SB(0, 0), cB, voffB[0], voffB[1]); G_STAGE(G_SA(0, 0), cA, voffA[0][0], voffA[0][1]);
    G_STAGE(G_SB(0, 1), cB + hstepB, voffB[0], voffB[1]); G_STAGE(G_SA(0, 1), cA + hstepA, voffA[1][0], voffA[1][1]);
    if (wr == 1) G_BAR;
    G_WAIT_V(4); G_BAR;
    G_STAGE(G_SB(1, 0), cB + kstep, voffB[0], voffB[1]); G_STAGE(G_SA(1, 0), cA + kstep, voffA[0][0], voffA[0][1]); G_STAGE(G_SB(1, 1), cB + hstepB + kstep, voffB[0], voffB[1]);
    G_WAIT_V(6); G_BAR;
    for (;;) {
        const bool has_next = unit_next<TY>(ui + 1, bid, npm, npn);
        const unsigned char* nA = has_next ? a_ptr(npm) : cA;
        const unsigned char* nB = has_next ? b_ptr(npm, npn) : cB;
        if constexpr (GATHER) {
            if (has_next) gather_off(npm, voffAn);
            else {
#pragma unroll
                for (int h = 0; h < 2; ++h)
#pragma unroll
                    for (int i = 0; i < 2; ++i) voffAn[h][i] = voffA[h][i];
            }
        }
        for (int t = 0; t < nt; t += 2) {
            const bool last = (t == nt - 2);
            const unsigned char* a1 = cA + (size_t)(t + 1) * kstep;
            const unsigned char* a2 = last ? nA : cA + (size_t)(t + 2) * kstep;
            const unsigned char* b2 = last ? nB : cB + (size_t)(t + 2) * kstep;
            const unsigned char* a3 = a2 + kstep;
            const unsigned char* b3 = b2 + kstep;
            unsigned va00 = voffA[0][0], va01 = voffA[0][1], va10 = voffA[1][0], va11 = voffA[1][1];
            if constexpr (GATHER) { if (last) { va00 = voffAn[0][0]; va01 = voffAn[0][1]; va10 = voffAn[1][0]; va11 = voffAn[1][1]; } }
            G_LDB(B0, 0, 0); G_SCHED; G_LDA(At, 0, 0); G_STAGE(G_SA(1, 1), a1 + hstepA, voffA[1][0], voffA[1][1]);
            G_WAIT_L(8); G_BAR; G_WAIT_L(0); G_MMA(0, 0, At, B0); G_BAR; G_SCHED;
            G_LDB(B1, 0, 1); G_STAGE(G_SB(0, 0), b2, voffB[0], voffB[1]);
            G_BAR; G_WAIT_L(0); G_MMA(0, 1, At, B1); G_BAR;
            G_LDA(At, 0, 1); G_STAGE(G_SA(0, 0), a2, va00, va01);
            G_BAR; G_WAIT_L(0); G_MMA(1, 0, At, B0); G_BAR; G_SCHED;
            G_STAGE(G_SB(0, 1), b2 + hstepB, voffB[0], voffB[1]);
            G_WAIT_V(6); G_BAR; G_MMA(1, 1, At, B1); G_BAR;
            G_LDB(B0, 1, 0); G_SCHED; G_LDA(At, 1, 0); G_STAGE(G_SA(0, 1), a2 + hstepA, va10, va11);
            G_WAIT_L(8); G_BAR; G_WAIT_L(0); G_MMA(0, 0, At, B0); G_BAR; G_SCHED;
            G_LDB(B1, 1, 1); G_STAGE(G_SB(1, 0), b3, voffB[0], voffB[1]);
            G_BAR; G_WAIT_L(0); G_MMA(0, 1, At, B1); G_BAR;
            G_LDA(At, 1, 1); G_STAGE(G_SA(1, 0), a3, va00, va01);
            G_BAR; G_WAIT_L(0); G_MMA(1, 0, At, B0); G_BAR; G_SCHED;
            G_STAGE(G_SB(1, 1), b3 + hstepB, voffB[0], voffB[1]);
            G_WAIT_V(6); G_BAR; G_MMA(1, 1, At, B1); G_BAR;
        }
        gemm_epilogue<TY>(acc, P, batch, cpm, cpn, wr, wc, fr, fq);
        if (!has_next) break;
#pragma unroll
        for (int a = 0; a < 2; ++a)
#pragma unroll
            for (int b = 0; b < 2; ++b)
#pragma unroll
                for (int m = 0; m < 4; ++m)
#pragma unroll
                    for (int n = 0; n < 2; ++n) acc[a][b][m][n] = (f32x4){0.f, 0.f, 0.f, 0.f};
        cpm = npm; cpn = npn; cA = nA; cB = nB; ++ui;
        if constexpr (GATHER) {
#pragma unroll
            for (int h = 0; h < 2; ++h)
#pragma unroll
                for (int i = 0; i < 2; ++i) voffA[h][i] = voffAn[h][i];
        }
    }
    G_WAIT_V(0);
    if (wr == 0) G_BAR;
    G_BAR;
#undef G_SA
#undef G_SB
#undef G_STAGE
#undef G_LDA
#undef G_LDB
#undef G_MMA
#undef G_WAIT_V
#undef G_WAIT_L
#undef G_BAR
#undef G_SCHED
}

#ifndef DBG_MASK
#define DBG_MASK 0
#endif
__device__ __forceinline__ void phase_dbg(const Params& P) {
    const int tid = otid();
    for (size_t i = (size_t)blockIdx.x * NTHREADS + tid; i < (size_t)NT * DM; i += (size_t)gridDim.x * NTHREADS) {
        float a = 0.f;
        for (int k = 0; k < 6; ++k) if ((DBG_MASK >> k) & 1) a += bf_lo(((const bf16_t*)(P.ws + (size_t)k * U))[i]);
        if ((DBG_MASK >> 6) & 1) a += ((const float*)(P.ws + WS_LR))[(i >> 10) * 32 + (i & 31)];
        P.out[i] = a;
    }
}

#define XB_TMO      128
#define XB_XCNT(j)  (256  + 64 * (j))
#define XB_XSUB(j)  (1280 + 64 * (j))
#define XB_XGEN(j)  (2304 + 64 * (j))
#define XB_TOP      3328
#define XB_TOPGEN   3392
#define XCD_BAR_WORDS 3456
#define XB_SPIN_CAP (1u << 18)
__device__ __forceinline__ unsigned xb_ld(unsigned* p)              { return __hip_atomic_load(p, __ATOMIC_RELAXED, __HIP_MEMORY_SCOPE_AGENT); }
__device__ __forceinline__ unsigned xb_add(unsigned* p, unsigned v) { return __hip_atomic_fetch_add(p, v, __ATOMIC_RELAXED, __HIP_MEMORY_SCOPE_AGENT); }
__device__ __forceinline__ unsigned xb_xcc_id() { return (unsigned)__builtin_amdgcn_s_getreg((3 << 11) | 20) & 0xFu; }
#define XB_SPIN(cond, bar) do { unsigned _sp = 0; while (cond) { __builtin_amdgcn_s_sleep(1); \
    if ((++_sp & 255u) == 0u) { if (xb_ld(&(bar)[XB_TMO])) break; if (_sp > XB_SPIN_CAP) { atomicAdd(&(bar)[XB_TMO], 1u); break; } } } } while (0)
struct XcdBarrier { unsigned* bar; unsigned x; volatile LAS unsigned* st; };
__device__ __forceinline__ XcdBarrier xcd_barrier_post(unsigned* bar, volatile LAS unsigned* st) {
    XcdBarrier b; b.bar = bar; b.x = xb_xcc_id(); b.st = st;
    if (threadIdx.x == 0) (void)xb_add(&bar[XB_XCNT(b.x)], 1u);
    return b;
}
__device__ __forceinline__ void xcd_barrier_complete(unsigned* bar, unsigned x, unsigned& nloc, unsigned& nx) {
    const unsigned G = gridDim.x * gridDim.y * gridDim.z;
    unsigned sum, cnt, mine, sp = 0u;
    for (;;) {
        sum = 0u; cnt = 0u; mine = 0u;
#pragma unroll
        for (unsigned j = 0; j < 16; ++j) { const unsigned c = xb_ld(&bar[XB_XCNT(j)]); sum += c; cnt += (c > 0u) ? 1u : 0u; mine = (j == x) ? c : mine; }
        if (sum == G) break;
        __builtin_amdgcn_s_sleep(1);
        if ((++sp & 255u) == 0u) { if (xb_ld(&bar[XB_TMO])) break; if (sp > XB_SPIN_CAP) { atomicAdd(&bar[XB_TMO], 1u); break; } }
    }
    nloc = mine > 0u ? mine : 1u; nx = cnt > 0u ? cnt : 1u;
}
__device__ __forceinline__ void xcd_barrier(const XcdBarrier& b) {
    asm volatile("s_waitcnt vmcnt(0)" ::: "memory");
    __syncthreads();
    if (threadIdx.x == 0) {
        unsigned* bar = b.bar;
        __builtin_amdgcn_s_waitcnt(0);
        unsigned nloc = b.st[0], nx = b.st[1];
        if (nloc == 0u) { xcd_barrier_complete(bar, b.x, nloc, nx); b.st[0] = nloc; b.st[1] = nx; }
        const unsigned old = xb_add(&bar[XB_XSUB(b.x)], 1u);
        const unsigned gen = old / nloc;
        if (old + 1u == (gen + 1u) * nloc) {
            __builtin_amdgcn_fence(__ATOMIC_RELEASE, "agent");
            asm volatile("s_waitcnt vmcnt(0)" ::: "memory");
            const unsigned og = xb_add(&bar[XB_TOP], 1u);
            const unsigned tg = og / nx;
            if (og + 1u == (tg + 1u) * nx) xb_add(&bar[XB_TOPGEN], 1u);
            else XB_SPIN(xb_ld(&bar[XB_TOPGEN]) == tg, bar);
            __builtin_amdgcn_fence(__ATOMIC_ACQUIRE, "agent");
            xb_add(&bar[XB_XGEN(b.x)], 1u);
            asm volatile("s_waitcnt vmcnt(0)" ::: "memory");
        } else {
            XB_SPIN(xb_ld(&bar[XB_XGEN(b.x)]) == gen, bar);
            __builtin_amdgcn_fence(__ATOMIC_ACQUIRE, "agent");
            asm volatile("s_waitcnt vmcnt(0)" ::: "memory");
        }
    }
    __syncthreads();
}

constexpr int N_PHASES = 21;
__global__ void __launch_bounds__(NTHREADS) mega_fwd(Params P) {
    extern __shared__ __attribute__((aligned(16))) unsigned char lds_raw[];
    LAS unsigned char* lds = (LAS unsigned char*)lds_raw;
    volatile LAS unsigned* xst = (volatile LAS unsigned*)(lds + 131072);
    if (threadIdx.x == 0) { xst[0] = 0u; xst[1] = 0u; xst[2] = 0u; xst[3] = 0u; }
    __syncthreads();
    const XcdBarrier xb = xcd_barrier_post((unsigned*)(P.ws + WS_BAR), xst);
    if (P.pad == 0x5A17) cg::this_grid().sync();
#define GSYNC() xcd_barrier(xb)
#ifndef PM
#endif
#ifndef DUP
#define DUP 0x4
#endif
#define PHASE(n, ...) if (((PM >> (n)) & 1) && P.ph_lo <= (n) && (n) < P.ph_hi) { __VA_ARGS__; if ((DUP >> (n)) & 1) { if (P.coop) GSYNC(); __VA_ARGS__; } if ((n) + 1 < P.ph_hi && P.coop) GSYNC(); }
    PHASE(0, if (blockIdx.x == 0 && threadIdx.x == 0) *(unsigned*)(P.ws + WS_CNT) = 0u; phase_mod(lds, P); phase_convert_mixer(lds, P))
    PHASE(1, phase_norm1(P))
    PHASE(2, gemm_phase<T_G1>(lds, P, 0))
    PHASE(3, phase_glaprep(lds, P); if (P.coop) GSYNC(); phase_gla(lds, P))
    PHASE(4, phase_oaprep(P))
    PHASE(5, gemm_phase<T_G1B>(lds, P, 0))
    PHASE(6, gemm_phase<T_G2>(lds, P, 0); gemm_phase<T_G3>(lds, P, 0))
    PHASE(8, gemm_phase<T_G4>(lds, P, 0))
    PHASE(9, phase_norm2(lds, P))
    PHASE(10, if (blockIdx.x < 32) phase_topk_item(lds, P, blockIdx.x); convert_moe(lds, P))
    for (int b = 0; b < 4; ++b) {
        if (((PM >> 11) & 1) && P.ph_lo <= 11 + 2 * b && 11 + 2 * b < P.ph_hi) { gemm_phase<T_GU>(lds, P, b); if (P.coop) GSYNC(); }
        if (((PM >> 12) & 1) && P.ph_lo <= 12 + 2 * b && 12 + 2 * b < P.ph_hi) { gemm_phase<T_DN>(lds, P, b); if (P.coop) GSYNC(); }
    }
#ifdef XSYNC
    if (P.coop) for (int i = 0; i < XSYNC; ++i) GSYNC();
#endif
    PHASE(19, phase_final(P))
    if (DBG_MASK && P.ph_lo <= 20 && 20 < P.ph_hi) phase_dbg(P);
}

extern "C" void kernel_launch(void* const* d_in, const int* in_sizes, int n_in, void* d_out, int out_size, void* d_ws, size_t ws_size, hipStream_t stream) {
    static int grid = 0;
    if (grid == 0) {
        int dev = 0, cus = 0, per_cu = 0;
        hipGetDevice(&dev);
        hipDeviceGetAttribute(&cus, hipDeviceAttributeMultiprocessorCount, dev);
        hipFuncSetAttribute((const void*)mega_fwd, hipFuncAttributeMaxDynamicSharedMemorySize, LDS_BYTES);
        hipOccupancyMaxActiveBlocksPerMultiprocessor(&per_cu, (const void*)mega_fwd, NTHREADS, LDS_BYTES);
        (void)hipGetLastError();
        grid = cus > 0 ? cus : 256;
        if (ws_size < ((size_t)1 << 30)) fprintf(stderr, "kernel_launch: workspace %zu smaller than the 1 GiB map\n", ws_size);
    }
    Params p{};
    for (int i = 0; i < 24; ++i) p.in[i] = (const float*)d_in[i];
    p.out = (float*)d_out; p.ws = (unsigned char*)d_ws;
#if MEGA
    (void)hipMemsetAsync((unsigned char*)d_ws + WS_BAR, 0, XCD_BAR_WORDS * sizeof(unsigned), stream);
    p.ph_lo = 0; p.ph_hi = N_PHASES; p.coop = 1; p.pad = 0;
    void* args[] = {&p};
    hipError_t e = hipLaunchCooperativeKernel((const void*)mega_fwd, dim3(grid), dim3(NTHREADS), args, LDS_BYTES, stream);
    if (e != hipSuccess) fprintf(stderr, "cooperative launch failed: %s (grid %d)\n", hipGetErrorString(e), grid);
#else
    for (int ph = 0; ph < N_PHASES; ++ph) {
        p.ph_lo = ph; p.ph_hi = ph + 1; p.coop = 0; p.pad = 0;
        hipLaunchKernelGGL(mega_fwd, dim3(grid), dim3(NTHREADS), LDS_BYTES, stream, p);
    }
#endif
}
```
